# Optimizing an MI355X kernel written in HIP

```python
import numpy as np
import jax
import jax.numpy as jnp
from jax import lax

D_MODEL = 1024
BATCH = 1
SEQ = 16384
DEPTH = 1

N_META = 16
GRID_W = 64
EPS = 1e-6

MLA_HEADS = 8
MLA_NOPE = 128
MLA_ROPE = 64
MLA_V = 128
MLA_Q_RANK = 256
MLA_KV_RANK = 256
MLA_WIDTH = MLA_HEADS * MLA_V
ROPE_BASE = 10000.0
Q_BLOCK = 128

NA_HEADS = 16
NA_HEAD_DIM = 64
NA_WIDTH = NA_HEADS * NA_HEAD_DIM
NA_WIN_R = 8
NA_WIN_C = 16

D_INNER = MLA_WIDTH + NA_WIDTH
IN_SIZES = (MLA_Q_RANK, MLA_KV_RANK, MLA_ROPE, MLA_WIDTH, NA_WIDTH, NA_WIDTH, NA_WIDTH, NA_WIDTH)
D_IN_PROJ = sum(IN_SIZES)

kernel_name = "hybrid_mla_neighbourhood_attention_encoder_layer"


def _rmsnorm(x, w):
    xf = x.astype(jnp.float32)
    y = xf * lax.rsqrt(jnp.mean(xf * xf, axis=-1, keepdims=True) + EPS)
    return (y * w.astype(jnp.float32)).astype(x.dtype)


def _rope(x, cos, sin):
    x1, x2 = jnp.split(x.astype(jnp.float32), 2, axis=-1)
    return jnp.concatenate([x1 * cos - x2 * sin, x2 * cos + x1 * sin], axis=-1).astype(x.dtype)


def _mla(q_lat, kv_lat, k_pe, w_uq, w_ukv, q_lat_w, kv_lat_w, qn_w, qpe_w, kn_w, kpe_w):
    B, L, _ = q_lat.shape
    q = (_rmsnorm(q_lat, q_lat_w) @ w_uq).reshape(B, L, MLA_HEADS, MLA_NOPE + MLA_ROPE)
    kv = (_rmsnorm(kv_lat, kv_lat_w) @ w_ukv).reshape(B, L, MLA_HEADS, MLA_NOPE + MLA_V)
    q_nope, q_pe = q[..., :MLA_NOPE], q[..., MLA_NOPE:]
    k_nope, v = kv[..., :MLA_NOPE], kv[..., MLA_NOPE:]
    q_nope = _rmsnorm(q_nope, qn_w)
    k_nope = _rmsnorm(k_nope, kn_w)
    pos = jnp.arange(L, dtype=jnp.float32)
    inv_freq = ROPE_BASE ** (-(jnp.arange(0, MLA_ROPE, 2, dtype=jnp.float32) / MLA_ROPE))
    ang = pos[:, None] * inv_freq[None, :]
    cos, sin = jnp.cos(ang), jnp.sin(ang)
    q_pe = _rope(_rmsnorm(q_pe, qpe_w), cos[None, :, None, :], sin[None, :, None, :])
    k_pe = _rope(_rmsnorm(k_pe, kpe_w), cos[None], sin[None])
    scale = (MLA_NOPE + MLA_ROPE) ** -0.5

    n_blk = -(-L // Q_BLOCK)
    pad = n_blk * Q_BLOCK - L
    qn = jnp.pad(q_nope, ((0, 0), (0, pad), (0, 0), (0, 0)))
    qn = qn.reshape(B, n_blk, Q_BLOCK, MLA_HEADS, MLA_NOPE).transpose(1, 0, 2, 3, 4)
    qp = jnp.pad(q_pe, ((0, 0), (0, pad), (0, 0), (0, 0)))
    qp = qp.reshape(B, n_blk, Q_BLOCK, MLA_HEADS, MLA_ROPE).transpose(1, 0, 2, 3, 4)

    def block(args):
        qn_b, qp_b = args
        s = (jnp.einsum('bqhd,bkhd->bhqk', qn_b, k_nope)
             + jnp.einsum('bqhr,bkr->bhqk', qp_b, k_pe))
        p = jax.nn.softmax(s.astype(jnp.float32) * scale, axis=-1).astype(v.dtype)
        return jnp.einsum('bhqk,bkhd->bqhd', p, v)

    o = lax.map(block, (qn, qp))
    o = o.transpose(1, 0, 2, 3, 4).reshape(B, n_blk * Q_BLOCK, MLA_WIDTH)
    return o[:, :L]


def _na(q, k, v, q_w, k_w, rel_bias, meta_bias):
    B, L, _ = q.shape
    n_real = L - N_META
    rows = n_real // GRID_W
    win_r = min(NA_WIN_R, rows)
    n_win = win_r * NA_WIN_C
    scale = NA_HEAD_DIM ** -0.5
    q = _rmsnorm(q.reshape(B, L, NA_HEADS, NA_HEAD_DIM), q_w)
    k = _rmsnorm(k.reshape(B, L, NA_HEADS, NA_HEAD_DIM), k_w)
    v = v.reshape(B, L, NA_HEADS, NA_HEAD_DIM)
    q_meta, k_meta, v_meta = q[:, :N_META], k[:, :N_META], v[:, :N_META]
    q_grid = q[:, N_META:].reshape(B, rows, GRID_W, NA_HEADS, NA_HEAD_DIM)
    k_grid = k[:, N_META:].reshape(B, rows, GRID_W, NA_HEADS, NA_HEAD_DIM)
    v_grid = v[:, N_META:].reshape(B, rows, GRID_W, NA_HEADS, NA_HEAD_DIM)

    cols = np.arange(GRID_W)
    c0 = np.clip(cols - NA_WIN_C // 2, 0, GRID_W - NA_WIN_C)
    col_idx_np = c0[:, None] + np.arange(NA_WIN_C)[None, :]
    col_idx = jnp.asarray(col_idx_np, dtype=jnp.int32)
    dc_idx = jnp.asarray(col_idx_np - cols[:, None] + (NA_WIN_C - 1), dtype=jnp.int32)
    meta_b = meta_bias.astype(jnp.float32)[None, :, None, :]

    def row_block(args):
        r, q_row = args
        r0 = jnp.clip(r - win_r // 2, 0, rows - win_r)
        k_rows = lax.dynamic_slice_in_dim(k_grid, r0, win_r, axis=1)
        v_rows = lax.dynamic_slice_in_dim(v_grid, r0, win_r, axis=1)
        k_win = k_rows[:, :, col_idx]
        v_win = v_rows[:, :, col_idx]
        dr_idx = r0 + jnp.arange(win_r, dtype=jnp.int32) - r + (NA_WIN_R - 1)
        bias = rel_bias[:, dr_idx[None, :, None], dc_idx[:, None, :]]
        s_win = (jnp.einsum('bqhd,brqchd->bhqrc', q_row, k_win).astype(jnp.float32) * scale
                 + bias.astype(jnp.float32)[None])
        s_meta = jnp.einsum('bqhd,bmhd->bhqm', q_row, k_meta).astype(jnp.float32) * scale + meta_b
        s = jnp.concatenate([s_win.reshape(B, NA_HEADS, GRID_W, n_win), s_meta], axis=-1)
        p = jax.nn.softmax(s, axis=-1).astype(v.dtype)
        p_win = p[..., :n_win].reshape(B, NA_HEADS, GRID_W, win_r, NA_WIN_C)
        p_meta = p[..., n_win:]
        return (jnp.einsum('bhqrc,brqchd->bqhd', p_win, v_win)
                + jnp.einsum('bhqm,bmhd->bqhd', p_meta, v_meta))

    o_grid = lax.map(row_block, (jnp.arange(rows, dtype=jnp.int32), q_grid.transpose(1, 0, 2, 3, 4)))
    o_real = o_grid.transpose(1, 0, 2, 3, 4).reshape(B, n_real, NA_WIDTH)

    s_mm = jnp.einsum('bqhd,bmhd->bhqm', q_meta, k_meta).astype(jnp.float32) * scale + meta_b
    p_mm = jax.nn.softmax(s_mm, axis=-1).astype(v.dtype)
    o_meta = jnp.einsum('bhqm,bmhd->bqhd', p_mm, v_meta).reshape(B, N_META, NA_WIDTH)
    return jnp.concatenate([o_meta, o_real], axis=1)


def setup_inputs(seed: int = 0) -> dict:
    key = jax.random.key(seed)
    ks = jax.random.split(key, 20)
    f32 = jnp.float32

    def nrm(k, shape, scale):
        return jax.random.normal(k, shape, f32) * scale

    def gain(k, shape):
        return 1.0 + 0.05 * jax.random.normal(k, shape, f32)

    return {
        "x": jax.random.normal(ks[0], (BATCH, SEQ, D_MODEL), f32),
        "meta_tokens": nrm(ks[1], (N_META, D_MODEL), 1.0),
        "norm_w": gain(ks[2], (DEPTH, D_MODEL)),
        "w_in": nrm(ks[3], (DEPTH, D_MODEL, D_IN_PROJ), D_MODEL ** -0.5),
        "q_lat_norm_w": gain(ks[4], (DEPTH, MLA_Q_RANK)),
        "kv_lat_norm_w": gain(ks[5], (DEPTH, MLA_KV_RANK)),
        "w_uq": nrm(ks[6], (DEPTH, MLA_Q_RANK, MLA_HEADS * (MLA_NOPE + MLA_ROPE)), MLA_Q_RANK ** -0.5),
        "w_ukv": nrm(ks[7], (DEPTH, MLA_KV_RANK, MLA_HEADS * (MLA_NOPE + MLA_V)), MLA_KV_RANK ** -0.5),
        "mla_qn_w": gain(ks[8], (DEPTH, MLA_NOPE)),
        "mla_qpe_w": gain(ks[9], (DEPTH, MLA_ROPE)),
        "mla_kn_w": gain(ks[10], (DEPTH, MLA_NOPE)),
        "mla_kpe_w": gain(ks[11], (DEPTH, MLA_ROPE)),
        "na_q_norm_w": gain(ks[12], (DEPTH, NA_HEAD_DIM)),
        "na_k_norm_w": gain(ks[13], (DEPTH, NA_HEAD_DIM)),
        "na_rel_bias": nrm(ks[14], (DEPTH, NA_HEADS, 2 * NA_WIN_R - 1, 2 * NA_WIN_C - 1), 0.5),
        "na_meta_bias": nrm(ks[15], (DEPTH, NA_HEADS, N_META), 0.5),
        "w_out": nrm(ks[16], (DEPTH, D_INNER, D_MODEL), D_INNER ** -0.5),
    }


def reference(x, meta_tokens, norm_w, w_in, q_lat_norm_w, kv_lat_norm_w, w_uq, w_ukv,
              mla_qn_w, mla_qpe_w, mla_kn_w, mla_kpe_w, na_q_norm_w, na_k_norm_w,
              na_rel_bias, na_meta_bias, w_out):
    B = x.shape[0]
    meta = jnp.broadcast_to(meta_tokens.astype(x.dtype)[None], (B, N_META, D_MODEL))
    h_res = jnp.concatenate([meta, x], axis=1)
    split_at = [int(s) for s in np.cumsum(IN_SIZES)[:-1]]
    for l in range(DEPTH):
        h = _rmsnorm(h_res, norm_w[l])
        proj = h @ w_in[l]
        q_lat, kv_lat, k_pe, g_mla, na_q, na_k, na_v, g_na = jnp.split(proj, split_at, axis=-1)
        y_mla = _mla(q_lat, kv_lat, k_pe, w_uq[l], w_ukv[l], q_lat_norm_w[l], kv_lat_norm_w[l],
                     mla_qn_w[l], mla_qpe_w[l], mla_kn_w[l], mla_kpe_w[l]) * jax.nn.silu(g_mla)
        y_na = _na(na_q, na_k, na_v, na_q_norm_w[l], na_k_norm_w[l],
                   na_rel_bias[l], na_meta_bias[l]) * jax.nn.silu(g_na)
        h_res = h_res + jnp.concatenate([y_mla, y_na], axis=-1) @ w_out[l]
    return h_res[:, N_META:]
```

```cpp
#include <hip/hip_runtime.h>
#include <hip/hip_bf16.h>
#include <hip/hip_cooperative_groups.h>
#include <cstdio>
#include <cstdint>
namespace cg = cooperative_groups;

#ifndef N_LAUNCHES
#define N_LAUNCHES 6
#endif

#define DEVINL __device__ __forceinline__
typedef unsigned short bf16_t;
using bf16x8 = __attribute__((ext_vector_type(8))) short;
using s16x4  = __attribute__((ext_vector_type(4))) short;
using f32x16 = __attribute__((ext_vector_type(16))) float;
using f32x4  = __attribute__((ext_vector_type(4))) float;
using u32x4  = __attribute__((ext_vector_type(4))) unsigned;
using u32x2  = __attribute__((ext_vector_type(2))) unsigned;

constexpr int DM = 1024, SEQ = 16384, NMETA = 16, L = SEQ + NMETA, LP = 16640;
constexpr int NPROJ = 5696, NPROJ_P = 5888;
constexpr int NHM = 8, NOPE = 128, ROPE = 64, VD = 128, QR = 256, KVR = 256;
constexpr int NHN = 16, DHN = 64;
constexpr float EPS = 1e-6f;
constexpr int NTHREADS = 512;
constexpr int LDS_BYTES = 131072 + 1024;

constexpr size_t OFF_WUQ  = 0;
constexpr size_t OFF_WUKV = OFF_WUQ + (size_t)1536 * 256 * 2;
constexpr size_t OFF_WOUT = OFF_WUKV + (size_t)2048 * 256 * 2;
constexpr size_t OFF_R1   = OFF_WOUT + (size_t)1024 * 2048 * 2;
constexpr size_t OFF_KPE  = OFF_R1 + (size_t)LP * 4;
constexpr size_t OFF_NAQ  = OFF_KPE + (size_t)LP * 64 * 2;
constexpr size_t OFF_NAK  = OFF_NAQ + (size_t)LP * 1024 * 2;
constexpr size_t OFF_VT   = OFF_NAK + (size_t)LP * 1024 * 2;
constexpr size_t OFF_KN   = OFF_VT + (size_t)LP * 1024 * 2;
constexpr size_t OFF_V    = OFF_KN + (size_t)8 * LP * 128 * 2;
constexpr size_t OFF_X    = OFF_V + (size_t)8 * LP * 128 * 2;
constexpr size_t OFF_QN   = OFF_X;
constexpr size_t OFF_QR   = OFF_QN + (size_t)8 * SEQ * 128 * 2;
constexpr size_t OFF_YM   = OFF_QR + (size_t)8 * SEQ * 64 * 2;
constexpr size_t WS_END   = OFF_YM + (size_t)SEQ * 1024 * 2;
constexpr size_t OFF_HB   = OFF_X;
constexpr size_t OFF_WIN  = OFF_HB + (size_t)LP * 1024 * 2;
constexpr size_t OFF_LAT  = OFF_YM;
static_assert(OFF_WIN + (size_t)NPROJ_P * 1024 * 2 <= OFF_YM, "Hb/WinT must not overlap LAT");
static_assert(OFF_LAT + (size_t)LP * 512 * 2 <= WS_END, "LAT fits");
static_assert(WS_END <= (size_t)256 * 1024 * 1024, "workspace fits 256 MiB");

struct Params {
  const float *x, *meta, *norm_w, *w_in, *qlw, *kvlw, *w_uq, *w_ukv, *qn_w, *qpe_w, *kn_w, *kpe_w, *naq_w, *nak_w, *relb, *metab, *w_out;
  float* out;
  unsigned char* ws;
};

DEVINL unsigned cvtpk(float lo, float hi) { unsigned r; asm("v_cvt_pk_bf16_f32 %0, %1, %2" : "=v"(r) : "v"(lo), "v"(hi)); return r; }
DEVINL unsigned cvtpk_v(float lo, float hi) { unsigned r; asm volatile("v_cvt_pk_bf16_f32 %0, %1, %2" : "=v"(r) : "v"(lo), "v"(hi)); return r; }
DEVINL float bf2f(unsigned short u) { return __uint_as_float(((unsigned)u) << 16); }
DEVINL float bflo(unsigned u) { return __uint_as_float(u << 16); }
DEVINL float bfhi(unsigned u) { return __uint_as_float(u & 0xffff0000u); }
DEVINL int crow(int r, int hi) { return (r & 3) + 8 * (r >> 2) + 4 * hi; }
DEVINL float silu(float v) { return v / (1.f + __expf(-v)); }
#define SBAR() __builtin_amdgcn_sched_barrier(0)
DEVINL int tidx() { int t = threadIdx.x; asm volatile("" : "+v"(t)); return t; }

DEVINL void tr_tile(const float* __restrict__ src, int sld, int sc0, int k0, const float* __restrict__ scale, bf16_t* __restrict__ dst, int dld, int n0, float* tile) {
  const int tid = tidx();
  __syncthreads();
  {
    const int kk = tid >> 4, nn = (tid & 15) * 4;
#pragma unroll
    for (int i = 0; i < 2; ++i) {
      const int k = kk + i * 32;
      float4 v = make_float4(0.f, 0.f, 0.f, 0.f);
      if (sc0 >= 0) {
        v = *reinterpret_cast<const float4*>(src + (size_t)(k0 + k) * sld + sc0 + nn);
        const float s = scale ? scale[k0 + k] : 1.f;
        v.x *= s; v.y *= s; v.z *= s; v.w *= s;
      }
      tile[k * 65 + nn + 0] = v.x; tile[k * 65 + nn + 1] = v.y; tile[k * 65 + nn + 2] = v.z; tile[k * 65 + nn + 3] = v.w;
    }
  }
  __syncthreads();
  {
    const int n = tid >> 3, kc = (tid & 7) * 8;
    float f[8];
#pragma unroll
    for (int j = 0; j < 8; ++j) f[j] = tile[(kc + j) * 65 + n];
    u32x4 w = {cvtpk(f[0], f[1]), cvtpk(f[2], f[3]), cvtpk(f[4], f[5]), cvtpk(f[6], f[7])};
    *reinterpret_cast<u32x4*>(dst + (size_t)(n0 + n) * dld + k0 + kc) = w;
  }
}

DEVINL void phase_prep(const Params& p, char* lds) {
  const int tid = tidx(), wave = tid >> 6, lane = tid & 63;
  bf16_t* Hb = (bf16_t*)(p.ws + OFF_HB);
  float* r1 = (float*)(p.ws + OFF_R1);
  for (int row = blockIdx.x * 8 + wave; row < LP; row += gridDim.x * 8) {
    bf16_t* dst = Hb + (size_t)row * DM;
    if (row < L) {
      const float* src = row < NMETA ? p.meta + (size_t)row * DM : p.x + (size_t)(row - NMETA) * DM;
      float ss = 0.f;
#pragma unroll
      for (int i = 0; i < 4; ++i) {
        float4 v = *reinterpret_cast<const float4*>(src + (lane + 64 * i) * 4);
        ss += v.x * v.x + v.y * v.y + v.z * v.z + v.w * v.w;
        u32x2 w = {cvtpk(v.x, v.y), cvtpk(v.z, v.w)};
        *reinterpret_cast<u32x2*>(dst + (lane + 64 * i) * 4) = w;
      }
#pragma unroll
      for (int o = 32; o >= 1; o >>= 1) ss += __shfl_xor(ss, o);
      if (lane == 0) r1[row] = rsqrtf(ss * (1.f / DM) + EPS);
    } else {
#pragma unroll
      for (int i = 0; i < 4; ++i) { u32x2 w = {0u, 0u}; *reinterpret_cast<u32x2*>(dst + (lane + 64 * i) * 4) = w; }
      if (lane == 0) r1[row] = 0.f;
    }
  }
  float* tile = (float*)lds;
  bf16_t* WinT = (bf16_t*)(p.ws + OFF_WIN); bf16_t* WuqT = (bf16_t*)(p.ws + OFF_WUQ);
  bf16_t* WukvT = (bf16_t*)(p.ws + OFF_WUKV); bf16_t* WoutT = (bf16_t*)(p.ws + OFF_WOUT);
  constexpr int J_IN = 92 * 16, J_UQ = 24 * 4, J_UKV = 32 * 4, J_OUT = 16 * 32;
  for (int j = blockIdx.x; j < J_IN + J_UQ + J_UKV + J_OUT; j += gridDim.x) {
    if (j < J_IN) {
      const int nb = j >> 4, kb = j & 15, n0 = nb * 64;
      int sc0;
      if (n0 < 512) sc0 = n0;
      else if (n0 < 1536) sc0 = n0 - 512 + 576;
      else if (n0 < 2560) sc0 = n0 - 1536 + 1600;
      else if (n0 < 3584) sc0 = n0 - 2560 + 2624;
      else if (n0 < 4608) sc0 = n0 - 3584 + 3648;
      else if (n0 < 5632) sc0 = n0 - 4608 + 4672;
      else if (n0 < 5696) sc0 = 512;
      else sc0 = -1;
      tr_tile(p.w_in, NPROJ, sc0, kb * 64, p.norm_w, WinT, DM, n0, tile);
    } else if (j < J_IN + J_UQ) {
      const int jj = j - J_IN, nb = jj >> 2, kb = jj & 3;
      const int sc0 = nb < 16 ? (nb >> 1) * 192 + (nb & 1) * 64 : (nb - 16) * 192 + 128;
      tr_tile(p.w_uq, 1536, sc0, kb * 64, p.qlw, WuqT, QR, nb * 64, tile);
    } else if (j < J_IN + J_UQ + J_UKV) {
      const int jj = j - J_IN - J_UQ, nb = jj >> 2, kb = jj & 3;
      tr_tile(p.w_ukv, 2048, nb * 64, kb * 64, p.kvlw, WukvT, KVR, nb * 64, tile);
    } else {
      const int jj = j - J_IN - J_UQ - J_UKV, nb = jj >> 5, kb = jj & 31;
      tr_tile(p.w_out, DM, nb * 64, kb * 64, nullptr, WoutT, 2048, nb * 64, tile);
    }
  }
}

constexpr int BK = 64, HALF = 128, HT = HALF * BK;
DEVINL int lds_byte(int r, int c) {
  int st = (r >> 4) * 2 + (c >> 5), rr = r & 15, cc = c & 31, ob = rr * 64 + cc * 2;
  return st * 1024 + (ob ^ (((ob >> 9) & 1) << 5));
}
DEVINL void stage_rc(int b, int& R, int& C) {
  int st = b / 1024, sb = b % 1024, swz = sb ^ (((sb >> 9) & 1) << 5);
  R = (st >> 1) * 16 + swz / 64; C = (st & 1) * 32 + (swz % 64) / 2;
}

template <bool SWAP, class Epi>
DEVINL void gemm_tile(const bf16_t* __restrict__ A0, const bf16_t* __restrict__ A1, int ksplit, int lda,
                      const bf16_t* __restrict__ Bt, int ldb, int nt, char* shmc, Epi epi) {
  bf16_t* shm = (bf16_t*)shmc;
#define SA(b, h) (shm + ((b) * 2 + (h)) * HT)
#define SB(b, h) (shm + (4 + (b) * 2 + (h)) * HT)
#define APTR(kt) (((kt) < ksplit ? A0 + (size_t)(kt) * BK : A1 + (size_t)((kt) - ksplit) * BK))
#define STAGE_A(P, hh, kt) do { const bf16_t* _base = APTR(kt) + (size_t)(hh) * HALF * lda; \
    __builtin_amdgcn_global_load_lds((const unsigned*)(_base + offA0), (__attribute__((address_space(3))) unsigned*)((char*)(P) + tid16), 16, 0, 0); \
    __builtin_amdgcn_global_load_lds((const unsigned*)(_base + offA1), (__attribute__((address_space(3))) unsigned*)((char*)(P) + tid16 + 8192), 16, 0, 0); } while (0)
#define STAGE_B(P, hh, kt) do { const bf16_t* _base = Bt + (size_t)(hh) * HALF * ldb + (size_t)(kt) * BK; \
    __builtin_amdgcn_global_load_lds((const unsigned*)(_base + offB0), (__attribute__((address_space(3))) unsigned*)((char*)(P) + tid16), 16, 0, 0); \
    __builtin_amdgcn_global_load_lds((const unsigned*)(_base + offB1), (__attribute__((address_space(3))) unsigned*)((char*)(P) + tid16 + 8192), 16, 0, 0); } while (0)
#define LDA(dst, b, h) for (int m = 0; m < 4; ++m) for (int k = 0; k < 2; ++k) \
    dst[m][k] = *reinterpret_cast<const bf16x8*>((char*)SA(b, h) + lds_byte(wr * 64 + m * 16 + fr, k * 32 + fq * 8))
#define LDB(dst, b, h) for (int n = 0; n < 2; ++n) for (int k = 0; k < 2; ++k) \
    dst[n][k] = *reinterpret_cast<const bf16x8*>((char*)SB(b, h) + lds_byte(wc * 32 + n * 16 + fr, k * 32 + fq * 8))
#define MMA(ai, bj, At, Bt_) do { __builtin_amdgcn_s_setprio(1); \
    for (int m = 0; m < 4; ++m) for (int n = 0; n < 2; ++n) for (int k = 0; k < 2; ++k) { \
      if (SWAP) acc[ai][bj][m][n] = __builtin_amdgcn_mfma_f32_16x16x32_bf16(Bt_[n][k], At[m][k], acc[ai][bj][m][n], 0, 0, 0); \
      else      acc[ai][bj][m][n] = __builtin_amdgcn_mfma_f32_16x16x32_bf16(At[m][k], Bt_[n][k], acc[ai][bj][m][n], 0, 0, 0); } \
    __builtin_amdgcn_s_setprio(0); } while (0)
#define WAIT_V(n) asm volatile("s_waitcnt vmcnt(" #n ")" ::: "memory")
#define WAIT_L(n) asm volatile("s_waitcnt lgkmcnt(" #n ")" ::: "memory")
#define BAR __builtin_amdgcn_s_barrier()
#define SCHED __builtin_amdgcn_sched_barrier(0)
  const int tid = tidx(), tid16 = tid * 16;
  int R0, C0, R1, C1; stage_rc(tid16, R0, C0); stage_rc(tid16 + 8192, R1, C1);
  const size_t offA0 = (size_t)R0 * lda + C0, offA1 = (size_t)R1 * lda + C1;
  const size_t offB0 = (size_t)R0 * ldb + C0, offB1 = (size_t)R1 * ldb + C1;
  const int wid = tid >> 6, lane = tid & 63, wr = wid >> 2, wc = wid & 3, fr = lane & 15, fq = lane >> 4;
  f32x4 acc[2][2][4][2] = {};
  bf16x8 At[4][2], B0[2][2], B1[2][2];
  WAIT_V(0);
  STAGE_B(SB(0, 0), 0, 0); STAGE_A(SA(0, 0), 0, 0);
  STAGE_B(SB(0, 1), 1, 0); STAGE_A(SA(0, 1), 1, 0);
  if (wr == 1) BAR;
  WAIT_V(4); BAR;
  STAGE_B(SB(1, 0), 0, 1); STAGE_A(SA(1, 0), 0, 1); STAGE_B(SB(1, 1), 1, 1);
  WAIT_V(6); BAR;
  for (int t = 0; t < nt - 2; t += 2) {
    LDB(B0, 0, 0); SCHED; LDA(At, 0, 0); STAGE_A(SA(1, 1), 1, t + 1);
    WAIT_L(8); BAR; WAIT_L(0); MMA(0, 0, At, B0); BAR; SCHED;
    LDB(B1, 0, 1); STAGE_B(SB(0, 0), 0, t + 2);
    BAR; WAIT_L(0); MMA(0, 1, At, B1); BAR;
    LDA(At, 0, 1); STAGE_A(SA(0, 0), 0, t + 2);
    BAR; WAIT_L(0); MMA(1, 0, At, B0); BAR; SCHED;
    STAGE_B(SB(0, 1), 1, t + 2);
    WAIT_V(6); BAR; MMA(1, 1, At, B1); BAR;
    LDB(B0, 1, 0); SCHED; LDA(At, 1, 0); STAGE_A(SA(0, 1), 1, t + 2);
    WAIT_L(8); BAR; WAIT_L(0); MMA(0, 0, At, B0); BAR; SCHED;
    LDB(B1, 1, 1); STAGE_B(SB(1, 0), 0, t + 3);
    BAR; WAIT_L(0); MMA(0, 1, At, B1); BAR;
    LDA(At, 1, 1); STAGE_A(SA(1, 0), 0, t + 3);
    BAR; WAIT_L(0); MMA(1, 0, At, B0); BAR; SCHED;
    STAGE_B(SB(1, 1), 1, t + 3);
    WAIT_V(6); BAR; MMA(1, 1, At, B1); BAR;
  }
  { LDB(B0, 0, 0); LDA(At, 0, 0); STAGE_A(SA(1, 1), 1, nt - 1);
    BAR; WAIT_L(0); MMA(0, 0, At, B0); BAR;
    LDB(B1, 0, 1); BAR; WAIT_L(0); MMA(0, 1, At, B1); BAR;
    LDA(At, 0, 1); WAIT_V(4); BAR; WAIT_L(0); MMA(1, 0, At, B0); MMA(1, 1, At, B1); BAR; }
  { LDB(B0, 1, 0); LDA(At, 1, 0); WAIT_V(2); BAR; WAIT_L(0); MMA(0, 0, At, B0); BAR;
    LDB(B1, 1, 1); WAIT_V(0); BAR; WAIT_L(0); MMA(0, 1, At, B1); BAR;
    LDA(At, 1, 1); BAR; WAIT_L(0); MMA(1, 0, At, B0); MMA(1, 1, At, B1); BAR; }
  if (wr == 0) BAR;
#pragma unroll
  for (int ai = 0; ai < 2; ++ai)
#pragma unroll
    for (int bj = 0; bj < 2; ++bj)
#pragma unroll
      for (int m = 0; m < 4; ++m)
#pragma unroll
        for (int n = 0; n < 2; ++n) {
          if (SWAP) epi(ai * HALF + wr * 64 + m * 16 + fr, bj * HALF + wc * 32 + n * 16 + fq * 4, acc[ai][bj][m][n]);
          else      epi(ai * HALF + wr * 64 + m * 16 + fq * 4, bj * HALF + wc * 32 + n * 16 + fr, acc[ai][bj][m][n]);
        }
#undef SA
#undef SB
#undef APTR
#undef STAGE_A
#undef STAGE_B
#undef LDA
#undef LDB
#undef MMA
}

DEVINL void phase_gemm1(const Params& p, char* lds) {
  const bf16_t* Hb = (const bf16_t*)(p.ws + OFF_HB); const bf16_t* WinT = (const bf16_t*)(p.ws + OFF_WIN);
  const float* r1 = (const float*)(p.ws + OFF_R1);
  bf16_t* LAT = (bf16_t*)(p.ws + OFF_LAT); bf16_t* KPE = (bf16_t*)(p.ws + OFF_KPE);
  bf16_t* NAQ = (bf16_t*)(p.ws + OFF_NAQ); bf16_t* NAK = (bf16_t*)(p.ws + OFF_NAK); bf16_t* VT = (bf16_t*)(p.ws + OFF_VT);
  bf16_t* G = (bf16_t*)p.out;
  constexpr int NM = LP / 256, NN = NPROJ_P / 256;
  for (int t = blockIdx.x; t < NM * NN; t += gridDim.x) {
    const int pm = t % NM, pn = t / NM, brow = pm * 256;
    const bf16_t* A = Hb + (size_t)brow * DM; const bf16_t* B = WinT + (size_t)pn * 256 * DM;
    if (pn >= 14 && pn < 18) {
      bf16_t* dst = VT + (size_t)(pn - 14) * 256 * LP + brow;
      const float* rr = r1 + brow;
      gemm_tile<false>(A, A, 1 << 30, DM, B, DM, DM / BK, lds, [=](int row, int col, f32x4 v) {
        const f32x4 s = *reinterpret_cast<const f32x4*>(rr + row);
        u32x2 w = {cvtpk(v[0] * s[0], v[1] * s[1]), cvtpk(v[2] * s[2], v[3] * s[3])};
        *reinterpret_cast<u32x2*>(dst + (size_t)col * LP + row) = w;
      });
    } else {
      bf16_t* dst; int ld, rlo = 0, rhi = LP, roff = 0, climit = 256; bool do_silu = false;
      if (pn < 2)        { dst = LAT + pn * 256; ld = 512; }
      else if (pn < 6)   { dst = G + (pn - 2) * 256; ld = 1024; rlo = NMETA; rhi = L; roff = NMETA; do_silu = true; }
      else if (pn < 10)  { dst = NAQ + (pn - 6) * 256; ld = 1024; }
      else if (pn < 14)  { dst = NAK + (pn - 10) * 256; ld = 1024; }
      else if (pn < 22)  { dst = G + (size_t)SEQ * 1024 + (pn - 18) * 256; ld = 1024; rlo = NMETA; rhi = L; roff = NMETA; do_silu = true; }
      else               { dst = KPE; ld = 64; climit = 64; }
      gemm_tile<true>(A, A, 1 << 30, DM, B, DM, DM / BK, lds, [=](int row, int col, f32x4 v) {
        const int grow = brow + row;
        if (grow >= rlo && grow < rhi && col < climit) {
          const float s = r1[grow];
          float a = v[0] * s, b = v[1] * s, c = v[2] * s, d = v[3] * s;
          if (do_silu) { a = silu(a); b = silu(b); c = silu(c); d = silu(d); }
          u32x2 w = {cvtpk(a, b), cvtpk(c, d)};
          *reinterpret_cast<u32x2*>(dst + (size_t)(grow - roff) * ld + col) = w;
        }
      });
    }
  }
}

DEVINL void phase_gemm2(const Params& p, char* lds) {
  const bf16_t* LAT = (const bf16_t*)(p.ws + OFF_LAT);
  const bf16_t* WuqT = (const bf16_t*)(p.ws + OFF_WUQ); const bf16_t* WukvT = (const bf16_t*)(p.ws + OFF_WUKV);
  bf16_t* KN = (bf16_t*)(p.ws + OFF_KN); bf16_t* V = (bf16_t*)(p.ws + OFF_V);
  bf16_t* QN = (bf16_t*)(p.ws + OFF_QN); bf16_t* QRp = (bf16_t*)(p.ws + OFF_QR);
  float* rs = (float*)(lds + 131072);
  constexpr int T_KV = (LP / 256) * 8, T_Q = (SEQ / 256) * 6;
  for (int t = blockIdx.x; t < T_KV + T_Q; t += gridDim.x) {
    const bool iskv = t < T_KV;
    int pm, pn; const bf16_t* A;
    if (iskv) { pm = t % (LP / 256); pn = t / (LP / 256); A = LAT + (size_t)pm * 256 * 512 + 256; }
    else { const int tt = t - T_KV; pm = tt % (SEQ / 256); pn = tt / (SEQ / 256); A = LAT + (size_t)(pm * 256 + NMETA) * 512; }
    __syncthreads();
    {
      const int row = tidx() >> 1, half = tidx() & 1;
      const bf16_t* src = A + (size_t)row * 512 + half * 128;
      float ss = 0.f;
#pragma unroll
      for (int i = 0; i < 16; ++i) {
        u32x4 w = *reinterpret_cast<const u32x4*>(src + i * 8);
#pragma unroll
        for (int j = 0; j < 4; ++j) { float a = bflo(w[j]), b = bfhi(w[j]); ss += a * a + b * b; }
      }
      ss += __shfl_xor(ss, 1);
      if (half == 0) rs[row] = rsqrtf(ss * (1.f / 256.f) + EPS);
    }
    __syncthreads();
    const int grow0 = pm * 256;
    if (iskv) {
      bf16_t* kd = KN + ((size_t)pn * LP + grow0) * 128; bf16_t* vd = V + ((size_t)pn * LP + grow0) * 128;
      gemm_tile<true>(A, A, 1 << 30, 512, WukvT + (size_t)pn * 256 * KVR, KVR, KVR / BK, lds, [=](int row, int col, f32x4 v) {
        const float s = rs[row];
        u32x2 w = {cvtpk(v[0] * s, v[1] * s), cvtpk(v[2] * s, v[3] * s)};
        bf16_t* d = col < 128 ? kd + (size_t)row * 128 + col : vd + (size_t)row * 128 + (col - 128);
        *reinterpret_cast<u32x2*>(d) = w;
      });
    } else if (pn < 4) {
      gemm_tile<true>(A, A, 1 << 30, 512, WuqT + (size_t)pn * 256 * QR, QR, QR / BK, lds, [=](int row, int col, f32x4 v) {
        const float s = rs[row];
        u32x2 w = {cvtpk(v[0] * s, v[1] * s), cvtpk(v[2] * s, v[3] * s)};
        const int n = pn * 256 + col, h = n >> 7, d = n & 127;
        *reinterpret_cast<u32x2*>(QN + ((size_t)h * SEQ + grow0 + row) * 128 + d) = w;
      });
    } else {
      gemm_tile<true>(A, A, 1 << 30, 512, WuqT + (size_t)pn * 256 * QR, QR, QR / BK, lds, [=](int row, int col, f32x4 v) {
        const float s = rs[row];
        u32x2 w = {cvtpk(v[0] * s, v[1] * s), cvtpk(v[2] * s, v[3] * s)};
        const int n = (pn - 4) * 256 + col, h = n >> 6, d = n & 63;
        *reinterpret_cast<u32x2*>(QRp + ((size_t)h * SEQ + grow0 + row) * 64 + d) = w;
      });
    }
  }
}

DEVINL void phase_gemm3(const Params& p, char* lds) {
  const bf16_t* YM = (const bf16_t*)(p.ws + OFF_YM); const bf16_t* YN = (const bf16_t*)(p.ws + OFF_NAQ) + (size_t)NMETA * 1024;
  const bf16_t* WoutT = (const bf16_t*)(p.ws + OFF_WOUT);
  for (int t = blockIdx.x; t < (SEQ / 256) * 4; t += gridDim.x) {
    const int pm = t % (SEQ / 256), pn = t / (SEQ / 256), brow = pm * 256;
    const float* xr = p.x + (size_t)brow * DM + pn * 256; float* od = p.out + (size_t)brow * DM + pn * 256;
    gemm_tile<true>(YM + (size_t)brow * 1024, YN + (size_t)brow * 1024, 16, 1024, WoutT + (size_t)pn * 256 * 2048, 2048, 2048 / BK, lds,
                    [=](int row, int col, f32x4 v) {
      const f32x4 xv = *reinterpret_cast<const f32x4*>(xr + (size_t)row * DM + col);
      f32x4 o = {xv[0] + v[0], xv[1] + v[1], xv[2] + v[2], xv[3] + v[3]};
      *reinterpret_cast<f32x4*>(od + (size_t)row * DM + col) = o;
    });
  }
}

template <int G, bool DOROPE>
DEVINL void norm_pass(bf16_t* base, long ngroups, const float* __restrict__ w, float outscale, int pos_mod, int pos_off) {
  constexpr int LPG = G / 8;
  const long gt = (long)blockIdx.x * NTHREADS + tidx(), nth = (long)gridDim.x * NTHREADS;
  const int sub = (int)(gt % LPG);
  float wv[8];
#pragma unroll
  for (int j = 0; j < 8; ++j) wv[j] = w[sub * 8 + j];
  for (long g = gt / LPG; g < ngroups; g += nth / LPG) {
    bf16_t* ptr = base + g * G + sub * 8;
    u32x4 raw = *reinterpret_cast<const u32x4*>(ptr);
    float f[8];
#pragma unroll
    for (int j = 0; j < 4; ++j) { f[2 * j] = bflo(raw[j]); f[2 * j + 1] = bfhi(raw[j]); }
    float ss = 0.f;
#pragma unroll
    for (int j = 0; j < 8; ++j) ss += f[j] * f[j];
#pragma unroll
    for (int o = 1; o < LPG; o <<= 1) ss += __shfl_xor(ss, o);
    const float r = rsqrtf(ss * (1.f / G) + EPS);
#pragma unroll
    for (int j = 0; j < 8; ++j) f[j] = f[j] * r * wv[j];
    if (DOROPE) {
      const float pos = (float)((int)(g % pos_mod) + pos_off);
#pragma unroll
      for (int j = 0; j < 8; ++j) {
        const float other = __shfl_xor(f[j], 4);
        const int i = (sub & 3) * 8 + j;
        const float invf = exp2f(-(float)i * (13.287712379549449f / 32.f));
        const float ang = pos * invf;
        const float k = rintf(ang * 0.15915494309189535f);
        float rr = fmaf(-k, 6.2831855f, ang); rr = fmaf(-k, -1.7484555e-7f, rr);
        const float c = __cosf(rr), s = __sinf(rr);
        f[j] = sub < 4 ? f[j] * c - other * s : f[j] * c + other * s;
      }
    }
    u32x4 o = {cvtpk(f[0] * outscale, f[1] * outscale), cvtpk(f[2] * outscale, f[3] * outscale),
               cvtpk(f[4] * outscale, f[5] * outscale), cvtpk(f[6] * outscale, f[7] * outscale)};
    *reinterpret_cast<u32x4*>(ptr) = o;
  }
}
DEVINL void phase_norm(const Params& p) {
  norm_pass<128, false>((bf16_t*)(p.ws + OFF_KN), (long)8 * LP, p.kn_w, 1.f, 1, 0);
  norm_pass<64, true>((bf16_t*)(p.ws + OFF_KPE), (long)LP, p.kpe_w, 1.f, LP, 0);
  norm_pass<128, false>((bf16_t*)(p.ws + OFF_QN), (long)8 * SEQ, p.qn_w, 1.f, 1, 0);
  norm_pass<64, true>((bf16_t*)(p.ws + OFF_QR), (long)8 * SEQ, p.qpe_w, 1.f, SEQ, NMETA);
  norm_pass<64, false>((bf16_t*)(p.ws + OFF_NAQ) + (size_t)NMETA * 1024, (long)SEQ * 16, p.naq_w, 0.125f, 1, 0);
  norm_pass<64, false>((bf16_t*)(p.ws + OFF_NAK), (long)L * 16, p.nak_w, 1.f, 1, 0);
}

constexpr float MLA_SCALE = 0.07216878364870322f;
constexpr float THR = 8.f;
constexpr int KVBLK = 64;
constexpr int NT_MLA = 258;
constexpr int SHM_V = 16384, SHM_K = 16384, SHM_KR = 8192;
constexpr int LDS_V = 0, LDS_K = 2 * SHM_V, LDS_KR = LDS_K + 2 * SHM_K, LDS_AW = LDS_KR + 2 * SHM_KR, LDS_QR = LDS_AW + 2048;
#define KSWZ(row, colB) ((row) * 256 + ((colB) ^ (((row) & 7) << 4)))
#define KRSWZ(row, colB) ((row) * 128 + ((colB) ^ (((row) & 7) << 4)))

DEVINL void partialSM(f32x16& p0, f32x16& p1, float& m_reg, float& mn, float& alpha, int kvalid, int hi) {
  constexpr float C = MLA_SCALE * 1.4426950408889634f;
#ifndef NO_MASK
  if (kvalid < 64)
#else
  if (false)
#endif
  {
#pragma unroll
    for (int r = 0; r < 16; ++r) { if (crow(r, hi) >= kvalid) p0[r] = -1e30f; if (32 + crow(r, hi) >= kvalid) p1[r] = -1e30f; }
  }
  float pmax = p0[0];
#pragma unroll
  for (int r = 1; r < 16; ++r) pmax = fmaxf(pmax, p0[r]);
#pragma unroll
  for (int r = 0; r < 16; ++r) pmax = fmaxf(pmax, p1[r]);
  { auto rr = __builtin_amdgcn_permlane32_swap(__float_as_uint(pmax), __float_as_uint(pmax), false, false);
    pmax = fmaxf(__uint_as_float(rr[0]), __uint_as_float(rr[1])); }
  if (__builtin_expect(__all(pmax - m_reg <= THR / MLA_SCALE), 1)) { mn = m_reg; alpha = 1.f; }
  else { mn = fmaxf(m_reg, pmax); alpha = __builtin_amdgcn_exp2f((m_reg - mn) * C); m_reg = mn; }
  const float mnC = -mn * C;
#pragma unroll
  for (int r = 0; r < 16; ++r) p0[r] = fmaf(p0[r], C, mnC);
#pragma unroll
  for (int r = 0; r < 16; ++r) p1[r] = fmaf(p1[r], C, mnC);
#pragma unroll
  for (int r = 0; r < 16; ++r) p0[r] = __builtin_amdgcn_exp2f(p0[r]);
}
#define PK4(P, BASE, OUT) do { unsigned a0 = cvtpk_v(P[BASE + 0], P[BASE + 1]), a1 = cvtpk_v(P[BASE + 2], P[BASE + 3]);   \
    unsigned b0 = cvtpk_v(P[BASE + 4], P[BASE + 5]), b1 = cvtpk_v(P[BASE + 6], P[BASE + 7]);                              \
    auto r0 = __builtin_amdgcn_permlane32_swap(a0, b0, false, false); auto r1 = __builtin_amdgcn_permlane32_swap(a1, b1, false, false); \
    u32x4 w = {r0[0], r1[0], r0[1], r1[1]}; OUT = *reinterpret_cast<bf16x8*>(&w); } while (0)
DEVINL void finishSM(f32x16& p0, f32x16& p1, float alpha, float& l_reg, bf16x8& pa0, bf16x8& pa1, bf16x8& pa2, bf16x8& pa3) {
#pragma unroll
  for (int r = 0; r < 16; ++r) p1[r] = __builtin_amdgcn_exp2f(p1[r]);
  float ps = 0;
#pragma unroll
  for (int r = 0; r < 16; ++r) ps += p0[r];
#pragma unroll
  for (int r = 0; r < 16; ++r) ps += p1[r];
  { auto rr = __builtin_amdgcn_permlane32_swap(__float_as_uint(ps), __float_as_uint(ps), false, false);
    ps = __uint_as_float(rr[0]) + __uint_as_float(rr[1]); }
  l_reg = l_reg * alpha + ps;
  PK4(p0, 0, pa0); PK4(p0, 8, pa1); PK4(p1, 0, pa2); PK4(p1, 8, pa3);
}
DEVINL void qkt(f32x16& p0, f32x16& p1, const char* Ks, const char* KRs, const bf16x8* qr, const char* QRs, int r32, int hi) {
  p0 = f32x16{}; p1 = f32x16{};
#pragma unroll
  for (int d0 = 0; d0 < 8; ++d0) { const int cb = (d0 * 16 + hi * 8) * 2;
    bf16x8 b0 = *reinterpret_cast<const bf16x8*>(Ks + KSWZ(r32, cb));
    bf16x8 b1 = *reinterpret_cast<const bf16x8*>(Ks + KSWZ(32 + r32, cb));
    p0 = __builtin_amdgcn_mfma_f32_32x32x16_bf16(b0, qr[d0], p0, 0, 0, 0);
    p1 = __builtin_amdgcn_mfma_f32_32x32x16_bf16(b1, qr[d0], p1, 0, 0, 0); }
#pragma unroll
  for (int d0 = 0; d0 < 4; ++d0) { const int cb = (d0 * 16 + hi * 8) * 2;
    bf16x8 b0 = *reinterpret_cast<const bf16x8*>(KRs + KRSWZ(r32, cb));
    bf16x8 b1 = *reinterpret_cast<const bf16x8*>(KRs + KRSWZ(32 + r32, cb));
    bf16x8 qv = *reinterpret_cast<const bf16x8*>(QRs + KRSWZ(r32, cb));
    p0 = __builtin_amdgcn_mfma_f32_32x32x16_bf16(b0, qv, p0, 0, 0, 0);
    p1 = __builtin_amdgcn_mfma_f32_32x32x16_bf16(b1, qv, p1, 0, 0, 0); }
}
DEVINL int v_st(int k, int c) { const int kk = (k & ~0xC) | ((k & 4) << 1) | ((k & 8) >> 1); return ((kk >> 3) * 4 + (c >> 5)) * 512 + ((kk & 7) * 32 + (c & 31)) * 2; }
DEVINL int v_rd_base(int lane) { return ((lane & 3) << 3) | (((lane >> 2) & 3) << 6) | (((lane >> 4) & 1) << 5) | (((lane >> 5) & 1) << 8); }
constexpr int v_rd_off(int d0, int ks, int half) { return d0 * 512 + ks * 4096 + half * 2048; }
template <int OFF> DEVINL s16x4 tr_read(int vb) {
  s16x4 r; asm volatile("ds_read_b64_tr_b16 %0, %1 offset:%2" : "=&v"(r) : "v"(vb), "i"(OFF) : "memory"); return r;
}
template <int D0> DEVINL void pv_one(f32x16& od, int vb, bf16x8 pa0, bf16x8 pa1, bf16x8 pa2, bf16x8 pa3) {
  const s16x4 l0 = tr_read<v_rd_off(D0, 0, 0)>(vb), h0 = tr_read<v_rd_off(D0, 0, 1)>(vb), l1 = tr_read<v_rd_off(D0, 1, 0)>(vb), h1 = tr_read<v_rd_off(D0, 1, 1)>(vb);
  const s16x4 l2 = tr_read<v_rd_off(D0, 2, 0)>(vb), h2 = tr_read<v_rd_off(D0, 2, 1)>(vb), l3 = tr_read<v_rd_off(D0, 3, 0)>(vb), h3 = tr_read<v_rd_off(D0, 3, 1)>(vb);
  asm volatile("s_waitcnt lgkmcnt(0)" ::: "memory"); SBAR();
#define PKV(Lo, Hi) (bf16x8){Lo[0], Lo[1], Lo[2], Lo[3], Hi[0], Hi[1], Hi[2], Hi[3]}
  od = __builtin_amdgcn_mfma_f32_32x32x16_bf16(pa0, PKV(l0, h0), od, 0, 0, 0);
  od = __builtin_amdgcn_mfma_f32_32x32x16_bf16(pa1, PKV(l1, h1), od, 0, 0, 0);
  od = __builtin_amdgcn_mfma_f32_32x32x16_bf16(pa2, PKV(l2, h2), od, 0, 0, 0);
  od = __builtin_amdgcn_mfma_f32_32x32x16_bf16(pa3, PKV(l3, h3), od, 0, 0, 0);
#undef PKV
}
DEVINL void pv_d0(f32x16* o, int vb, bf16x8 pa0, bf16x8 pa1, bf16x8 pa2, bf16x8 pa3) {
  pv_one<0>(o[0], vb, pa0, pa1, pa2, pa3); pv_one<1>(o[1], vb, pa0, pa1, pa2, pa3); pv_one<2>(o[2], vb, pa0, pa1, pa2, pa3); pv_one<3>(o[3], vb, pa0, pa1, pa2, pa3);
}

DEVINL void mla_block(const bf16_t* __restrict__ Qn, const bf16_t* __restrict__ Qr, const bf16_t* __restrict__ Kn, const bf16_t* __restrict__ Kpe,
                      const bf16_t* __restrict__ Vh, const bf16_t* __restrict__ Gb, bf16_t* __restrict__ Yb, char* lds) {
  const int tid = tidx(), wid = tid >> 6, lane = tid & 63, r32 = lane & 31, hi = lane >> 5;
  char* V_lds = lds + LDS_V; char* K_lds = lds + LDS_K; char* KR_lds = lds + LDS_KR;
  float* ws = (float*)(lds + LDS_AW) + wid * 64; float* li_l = ws; float* al_l = ws + 32;
  float m_reg = -1e30f, l_reg = 0; f32x16 o[4] = {}; bf16x8 qr[8];
  char* QRs = lds + LDS_QR + wid * 4096;
  __syncthreads();
  {
    const bf16_t* Qw = Qn + (size_t)(wid * 32 + r32) * 128 + hi * 8;
#pragma unroll
    for (int d0 = 0; d0 < 8; ++d0) qr[d0] = *reinterpret_cast<const bf16x8*>(Qw + d0 * 16);
    const bf16_t* Qw2 = Qr + (size_t)(wid * 32 + r32) * 64 + hi * 8;
#pragma unroll
    for (int d0 = 0; d0 < 4; ++d0) *(bf16x8*)(QRs + KRSWZ(r32, (d0 * 16 + hi * 8) * 2)) = *reinterpret_cast<const bf16x8*>(Qw2 + d0 * 16);
  }
  const int sr = tid >> 4, sc = (tid & 15) * 8, vst0 = v_st(sr, sc), vst1 = v_st(32 + sr, sc);
  const int rr_ = tid >> 3, rc_ = (tid & 7) * 8;
  const int vb0 = (int)(uintptr_t)(__attribute__((address_space(3))) char*)V_lds + v_rd_base(lane);
  bf16x8 vs0, vs1, ks0, ks1, kr0;
#define SLOAD(k0) do { vs0 = *reinterpret_cast<const bf16x8*>(&Vh[(size_t)((k0) + sr) * 128 + sc]); vs1 = *reinterpret_cast<const bf16x8*>(&Vh[(size_t)((k0) + 32 + sr) * 128 + sc]); \
    ks0 = *reinterpret_cast<const bf16x8*>(&Kn[(size_t)((k0) + sr) * 128 + sc]); ks1 = *reinterpret_cast<const bf16x8*>(&Kn[(size_t)((k0) + 32 + sr) * 128 + sc]); \
    kr0 = *reinterpret_cast<const bf16x8*>(&Kpe[(size_t)((k0) + rr_) * 64 + rc_]); } while (0)
#define SWRITE(b) do { *(bf16x8*)(V_lds + (b) * SHM_V + vst0) = vs0; *(bf16x8*)(V_lds + (b) * SHM_V + vst1) = vs1; const int kc = sc * 2; \
    *(bf16x8*)(K_lds + (b) * SHM_K + KSWZ(sr, kc)) = ks0; *(bf16x8*)(K_lds + (b) * SHM_K + KSWZ(32 + sr, kc)) = ks1; \
    *(bf16x8*)(KR_lds + (b) * SHM_KR + KRSWZ(rr_, rc_ * 2)) = kr0; } while (0)
#define SWAIT() asm volatile("s_waitcnt vmcnt(0)" ::: "memory")
#define RESC(a) do { if (__any((a) < 1.f)) { if (hi == 0) al_l[r32] = (a); asm volatile("s_waitcnt lgkmcnt(0)" ::: "memory"); \
    for (int d = 0; d < 4; ++d) for (int r = 0; r < 16; ++r) o[d][r] *= al_l[crow(r, hi)]; } } while (0)
  f32x16 p0, p1; float mn, al; bf16x8 pa0, pa1, pa2, pa3; constexpr int NT = NT_MLA;
  SLOAD(0); SWAIT(); SWRITE(0); __syncthreads();
  for (int j = 0; j < NT; ++j) {
    const int b = j & 1;
    if (j + 1 < NT) SLOAD((j + 1) * KVBLK);
    SBAR();
    qkt(p0, p1, K_lds + b * SHM_K, KR_lds + b * SHM_KR, qr, QRs, r32, hi);
    partialSM(p0, p1, m_reg, mn, al, L - j * KVBLK, hi);
    RESC(al);
    finishSM(p0, p1, al, l_reg, pa0, pa1, pa2, pa3); SBAR();
    pv_d0(o, vb0 + b * SHM_V, pa0, pa1, pa2, pa3);
    if (j + 1 < NT) { SWAIT(); SWRITE(b ^ 1); }
    __syncthreads();
  }
  if (hi == 0) li_l[r32] = l_reg; asm volatile("s_waitcnt lgkmcnt(0)" ::: "memory");
  float rli[16];
#pragma unroll
  for (int r = 0; r < 16; ++r) rli[r] = __builtin_amdgcn_rcpf(li_l[crow(r, hi)]);
  __syncthreads();
  float* ost = (float*)(lds + wid * 16384);
  {
    float* ow = ost + (4 * hi) * 128 + r32;
#pragma unroll
    for (int r = 0; r < 16; ++r)
#pragma unroll
      for (int d0 = 0; d0 < 4; ++d0) ow[((r & 3) + 8 * (r >> 2)) * 128 + d0 * 32] = o[d0][r] * rli[r];
  }
  asm volatile("s_waitcnt lgkmcnt(0)" ::: "memory");
  for (int it = 0; it < 8; ++it) {
    const int c = it * 64 + lane, row = c >> 4, col = (c & 15) * 8;
    const f32x4 a = *reinterpret_cast<const f32x4*>(ost + row * 128 + col), bq = *reinterpret_cast<const f32x4*>(ost + row * 128 + col + 4);
    const size_t off = (size_t)(wid * 32 + row) * 1024 + col;
    const u32x4 g = *reinterpret_cast<const u32x4*>(Gb + off);
    u32x4 y = {cvtpk(a[0] * bflo(g[0]), a[1] * bfhi(g[0])), cvtpk(a[2] * bflo(g[1]), a[3] * bfhi(g[1])),
               cvtpk(bq[0] * bflo(g[2]), bq[1] * bfhi(g[2])), cvtpk(bq[2] * bflo(g[3]), bq[3] * bfhi(g[3]))};
    *reinterpret_cast<u32x4*>(Yb + off) = y;
  }
#undef SLOAD
#undef SWRITE
#undef SWAIT
#undef RESC
}

constexpr float LOG2E = 1.4426950408889634f;
DEVINL void na_item(const Params& p, int r, int h, const float* relb_l, const float* metab_l) {
  const int lane = tidx() & 63, r32 = lane & 31, hi = lane >> 5;
  bf16_t* NAQ = (bf16_t*)(p.ws + OFF_NAQ); const bf16_t* NAK = (const bf16_t*)(p.ws + OFF_NAK); const bf16_t* VT = (const bf16_t*)(p.ws + OFF_VT);
  const bf16_t* G = (const bf16_t*)p.out + (size_t)SEQ * 1024;
  const int r0 = min(max(r - 4, 0), 256 - 8);
  const bf16_t* vt0 = VT + (size_t)(h * 64 + r32) * LP + hi * 8;
  const bf16_t* vt1 = vt0 + (size_t)32 * LP;
  for (int qh = 0; qh < 2; ++qh) {
    const int qc = qh * 32 + r32;
    const size_t qtok = NMETA + r * 64 + qc;
    bf16x8 qf[4];
#pragma unroll
    for (int d0 = 0; d0 < 4; ++d0) qf[d0] = *reinterpret_cast<const bf16x8*>(NAQ + qtok * 1024 + h * 64 + d0 * 16 + hi * 8);
    const int c0 = min(max(qc - 8, 0), 48);
    float m = -1e30f, l = 0.f; f32x16 o0 = {}, o1 = {};
    for (int step = 0; step < 8; ++step) {
      const size_t tok0 = NMETA + (size_t)(r0 + step) * 64;
      f32x16 s0 = {}, s1 = {};
      const bf16_t* kp = NAK + (tok0 + r32) * 1024 + h * 64 + hi * 8;
#pragma unroll
      for (int d0 = 0; d0 < 4; ++d0) {
        bf16x8 k0 = *reinterpret_cast<const bf16x8*>(kp + d0 * 16);
        bf16x8 k1 = *reinterpret_cast<const bf16x8*>(kp + (size_t)32 * 1024 + d0 * 16);
        s0 = __builtin_amdgcn_mfma_f32_32x32x16_bf16(k0, qf[d0], s0, 0, 0, 0);
        s1 = __builtin_amdgcn_mfma_f32_32x32x16_bf16(k1, qf[d0], s1, 0, 0, 0);
      }
      const float* bp = relb_l + h * 465 + (r0 + step - r + 7) * 31;
      float pmax = -1e30f;
#pragma unroll
      for (int reg = 0; reg < 16; ++reg) {
        const int kc = crow(reg, hi), kc2 = 32 + kc;
        const int i0 = min(max(kc - qc + 15, 0), 30), i1 = min(max(kc2 - qc + 15, 0), 30);
        const float b0 = bp[i0], b1 = bp[i1];
        s0[reg] = (kc >= c0 && kc < c0 + 16) ? fmaf(s0[reg], LOG2E, b0) : -1e30f;
        s1[reg] = (kc2 >= c0 && kc2 < c0 + 16) ? fmaf(s1[reg], LOG2E, b1) : -1e30f;
        pmax = fmaxf(pmax, fmaxf(s0[reg], s1[reg]));
      }
      { auto rr = __builtin_amdgcn_permlane32_swap(__float_as_uint(pmax), __float_as_uint(pmax), false, false);
        pmax = fmaxf(__uint_as_float(rr[0]), __uint_as_float(rr[1])); }
      const float mn = fmaxf(m, pmax), alpha = __builtin_amdgcn_exp2f(m - mn); m = mn;
      float ps = 0.f;
#pragma unroll
      for (int reg = 0; reg < 16; ++reg) { s0[reg] = __builtin_amdgcn_exp2f(s0[reg] - mn); s1[reg] = __builtin_amdgcn_exp2f(s1[reg] - mn); ps += s0[reg] + s1[reg]; }
      { auto rr = __builtin_amdgcn_permlane32_swap(__float_as_uint(ps), __float_as_uint(ps), false, false);
        ps = __uint_as_float(rr[0]) + __uint_as_float(rr[1]); }
      l = l * alpha + ps;
#pragma unroll
      for (int reg = 0; reg < 16; ++reg) { o0[reg] *= alpha; o1[reg] *= alpha; }
      bf16x8 pa[4];
      PK4(s0, 0, pa[0]); PK4(s0, 8, pa[1]); PK4(s1, 0, pa[2]); PK4(s1, 8, pa[3]);
#pragma unroll
      for (int ks = 0; ks < 4; ++ks) {
        bf16x8 v0 = *reinterpret_cast<const bf16x8*>(vt0 + tok0 + ks * 16);
        bf16x8 v1 = *reinterpret_cast<const bf16x8*>(vt1 + tok0 + ks * 16);
        o0 = __builtin_amdgcn_mfma_f32_32x32x16_bf16(v0, pa[ks], o0, 0, 0, 0);
        o1 = __builtin_amdgcn_mfma_f32_32x32x16_bf16(v1, pa[ks], o1, 0, 0, 0);
      }
    }
    {
      f32x16 s0 = {};
      const bf16_t* kp = NAK + (size_t)r32 * 1024 + h * 64 + hi * 8;
#pragma unroll
      for (int d0 = 0; d0 < 4; ++d0) {
        bf16x8 k0 = *reinterpret_cast<const bf16x8*>(kp + d0 * 16);
        s0 = __builtin_amdgcn_mfma_f32_32x32x16_bf16(k0, qf[d0], s0, 0, 0, 0);
      }
      float pmax = -1e30f;
#pragma unroll
      for (int reg = 0; reg < 16; ++reg) {
        const int mk = crow(reg, hi);
        s0[reg] = mk < 16 ? fmaf(s0[reg], LOG2E, metab_l[h * 16 + (mk & 15)]) : -1e30f;
        pmax = fmaxf(pmax, s0[reg]);
      }
      { auto rr = __builtin_amdgcn_permlane32_swap(__float_as_uint(pmax), __float_as_uint(pmax), false, false);
        pmax = fmaxf(__uint_as_float(rr[0]), __uint_as_float(rr[1])); }
      const float mn = fmaxf(m, pmax), alpha = __builtin_amdgcn_exp2f(m - mn); m = mn;
      float ps = 0.f;
#pragma unroll
      for (int reg = 0; reg < 16; ++reg) { s0[reg] = __builtin_amdgcn_exp2f(s0[reg] - mn); ps += s0[reg]; }
      { auto rr = __builtin_amdgcn_permlane32_swap(__float_as_uint(ps), __float_as_uint(ps), false, false);
        ps = __uint_as_float(rr[0]) + __uint_as_float(rr[1]); }
      l = l * alpha + ps;
#pragma unroll
      for (int reg = 0; reg < 16; ++reg) { o0[reg] *= alpha; o1[reg] *= alpha; }
      bf16x8 pa0;
      PK4(s0, 0, pa0);
      bf16x8 v0 = *reinterpret_cast<const bf16x8*>(vt0);
      bf16x8 v1 = *reinterpret_cast<const bf16x8*>(vt1);
      o0 = __builtin_amdgcn_mfma_f32_32x32x16_bf16(v0, pa0, o0, 0, 0, 0);
      o1 = __builtin_amdgcn_mfma_f32_32x32x16_bf16(v1, pa0, o1, 0, 0, 0);
    }
    const float rl = __builtin_amdgcn_rcpf(l);
    const bf16_t* gp = G + (qtok - NMETA) * 1024 + h * 64;
    bf16_t* yp = NAQ + qtok * 1024 + h * 64;
#pragma unroll
    for (int q4 = 0; q4 < 4; ++q4) {
      const int d = 8 * q4 + 4 * hi;
      const u32x2 g0 = *reinterpret_cast<const u32x2*>(gp + d), g1 = *reinterpret_cast<const u32x2*>(gp + 32 + d);
      u32x2 w0 = {cvtpk(o0[4 * q4 + 0] * rl * bflo(g0[0]), o0[4 * q4 + 1] * rl * bfhi(g0[0])), cvtpk(o0[4 * q4 + 2] * rl * bflo(g0[1]), o0[4 * q4 + 3] * rl * bfhi(g0[1]))};
      u32x2 w1 = {cvtpk(o1[4 * q4 + 0] * rl * bflo(g1[0]), o1[4 * q4 + 1] * rl * bfhi(g1[0])), cvtpk(o1[4 * q4 + 2] * rl * bflo(g1[1]), o1[4 * q4 + 3] * rl * bfhi(g1[1]))};
      *reinterpret_cast<u32x2*>(yp + d) = w0; *reinterpret_cast<u32x2*>(yp + 32 + d) = w1;
    }
  }
}

DEVINL void phase_attn(const Params& p, char* lds) {
#ifndef NO_MLA
  {
    const bf16_t* QN = (const bf16_t*)(p.ws + OFF_QN); const bf16_t* QRp = (const bf16_t*)(p.ws + OFF_QR);
    const bf16_t* KN = (const bf16_t*)(p.ws + OFF_KN); const bf16_t* KPE = (const bf16_t*)(p.ws + OFF_KPE); const bf16_t* V = (const bf16_t*)(p.ws + OFF_V);
    const bf16_t* G = (const bf16_t*)p.out; bf16_t* YM = (bf16_t*)(p.ws + OFF_YM);
    for (int it = blockIdx.x; it < 512; it += gridDim.x) {
      const int h = it & 7, qb = it >> 3;
      mla_block(QN + ((size_t)h * SEQ + qb * 256) * 128, QRp + ((size_t)h * SEQ + qb * 256) * 64, KN + (size_t)h * LP * 128, KPE, V + (size_t)h * LP * 128,
                G + (size_t)qb * 256 * 1024 + h * 128, YM + (size_t)qb * 256 * 1024 + h * 128, lds);
    }
  }
#endif
#ifndef NO_NA
  __syncthreads();
  float* relb_l = (float*)lds; float* metab_l = relb_l + 16 * 465;
  for (int i = tidx(); i < 16 * 465; i += NTHREADS) relb_l[i] = p.relb[i] * LOG2E;
  for (int i = tidx(); i < 256; i += NTHREADS) metab_l[i] = p.metab[i] * LOG2E;
  __syncthreads();
  const int wave = tidx() >> 6;
  for (int r = blockIdx.x; r < 256; r += gridDim.x) {
    na_item(p, r, wave, relb_l, metab_l);
    na_item(p, r, wave + 8, relb_l, metab_l);
  }
#endif
}

__global__ void __launch_bounds__(NTHREADS) mega(Params p, int ph_lo, int ph_hi) {
  extern __shared__ __attribute__((aligned(16))) char shm[];
  cg::grid_group grid = cg::this_grid();
  for (int ph = ph_lo; ph < ph_hi; ++ph) {
    if (ph > ph_lo) grid.sync();
#ifdef ONLY_PHASE
    if (ONLY_PHASE == 0) phase_prep(p, shm);
    if (ONLY_PHASE == 1) phase_gemm1(p, shm);
    if (ONLY_PHASE == 2) phase_gemm2(p, shm);
    if (ONLY_PHASE == 3) phase_norm(p);
    if (ONLY_PHASE == 4) phase_attn(p, shm);
    if (ONLY_PHASE == 5) phase_gemm3(p, shm);
#else
    if (ph == 0) phase_prep(p, shm);
    else if (ph == 1) phase_gemm1(p, shm);
    else if (ph == 2) phase_gemm2(p, shm);
    else if (ph == 3) phase_norm(p);
    else if (ph == 4) phase_attn(p, shm);
    else phase_gemm3(p, shm);
#endif
  }
}

extern "C" void kernel_launch(void* const* d_in, const int* in_sizes, int n_in, void* d_out, int out_size, void* d_ws, size_t ws_size, hipStream_t stream) {
  static int grid = 0;
  if (grid == 0) {
    if (n_in != 17 || in_sizes[0] != SEQ * DM || out_size != SEQ * DM || ws_size < WS_END) {
      fprintf(stderr, "kernel_launch: shape mismatch n_in %d in0 %d out %d ws %zu (need %zu)\n", n_in, n_in > 0 ? in_sizes[0] : -1, out_size, ws_size, (size_t)WS_END);
      grid = -1; return; }
    int dev = 0, cus = 0, per_cu = 0;
    hipGetDevice(&dev);
    hipDeviceGetAttribute(&cus, hipDeviceAttributeMultiprocessorCount, dev);
    if (hipFuncSetAttribute((const void*)mega, hipFuncAttributeMaxDynamicSharedMemorySize, LDS_BYTES) != hipSuccess) { fprintf(stderr, "kernel_launch: hipFuncSetAttribute failed\n"); grid = -1; return; }
    if (hipOccupancyMaxActiveBlocksPerMultiprocessor(&per_cu, (const void*)mega, NTHREADS, LDS_BYTES) != hipSuccess || per_cu < 1) {
      fprintf(stderr, "kernel_launch: occupancy query gave %d\n", per_cu); (void)hipGetLastError(); per_cu = 1; }
    grid = cus * 1;
    if (grid <= 0) grid = 256;
  }
  if (grid < 0) return;
  Params p{};
  const float** f = (const float**)&p;
  for (int i = 0; i < 17; ++i) f[i] = (const float*)d_in[i];
  p.out = (float*)d_out; p.ws = (unsigned char*)d_ws;
#if N_LAUNCHES == 1
  int lo = 0, hi = 6;
  void* args[] = {&p, &lo, &hi};
  hipError_t e = hipLaunchCooperativeKernel((const void*)mega, dim3(grid), dim3(NTHREADS), args, LDS_BYTES, stream);
  if (e != hipSuccess) fprintf(stderr, "cooperative launch failed: %s (grid %d)\n", hipGetErrorString(e), grid);
#else
  for (int ph = 0; ph < 6; ++ph) {
    hipLaunchKernelGGL(mega, dim3(grid), dim3(NTHREADS), LDS_BYTES, stream, p, ph, ph + 1);
  }
  hipError_t e = hipPeekAtLastError();
  if (e != hipSuccess) fprintf(stderr, "launch failed: %s\n", hipGetErrorString(e));
#endif
}
```

```cpp
#include <hip/hip_runtime.h>
#include <hip/hip_bf16.h>
#include <hip/hip_cooperative_groups.h>
#include <cstdio>
#include <cstdint>
namespace cg = cooperative_groups;

#ifndef N_LAUNCHES
#define N_LAUNCHES 1
#endif

#define DEVINL __device__ __forceinline__
typedef unsigned short bf16_t;
using bf16x8 = __attribute__((ext_vector_type(8))) short;
using s16x4  = __attribute__((ext_vector_type(4))) short;
using f32x16 = __attribute__((ext_vector_type(16))) float;
using f32x4  = __attribute__((ext_vector_type(4))) float;
using u32x4  = __attribute__((ext_vector_type(4))) unsigned;
using u32x2  = __attribute__((ext_vector_type(2))) unsigned;
using f32x2  = __attribute__((ext_vector_type(2))) float;

constexpr int DM = 1024, SEQ = 16384, NMETA = 16, L = SEQ + NMETA, LP = 16640;
constexpr int NPROJ = 5696, NPROJ_P = 5888;
constexpr int NHM = 8, NOPE = 128, ROPE = 64, VD = 128, QR = 256, KVR = 256;
constexpr int NHN = 16, DHN = 64;
constexpr float EPS = 1e-6f;
constexpr int NTHREADS = 512;
constexpr int LDS_XB = 131072 + 1024;
constexpr int LDS_BYTES = LDS_XB + 256;

constexpr size_t OFF_WUQ  = 0;
constexpr size_t OFF_WUKV = OFF_WUQ + (size_t)1536 * 256 * 2;
constexpr size_t OFF_WOUT = OFF_WUKV + (size_t)2048 * 256 * 2;
constexpr size_t OFF_R1   = OFF_WOUT + (size_t)1024 * 2048 * 2;
constexpr size_t OFF_KPE  = OFF_R1 + (size_t)LP * 4;
constexpr size_t OFF_NAQ  = OFF_KPE + (size_t)LP * 64 * 2;
constexpr size_t OFF_NAK  = OFF_NAQ + (size_t)LP * 1024 * 2;
constexpr size_t OFF_VT   = OFF_NAK + (size_t)LP * 1024 * 2;
constexpr size_t OFF_KN   = OFF_VT + (size_t)LP * 1024 * 2;
constexpr size_t OFF_V    = OFF_KN + (size_t)8 * LP * 128 * 2;
constexpr size_t OFF_X    = OFF_V + (size_t)8 * LP * 128 * 2;
constexpr size_t OFF_QN   = OFF_X;
constexpr size_t OFF_QR   = OFF_QN + (size_t)8 * SEQ * 128 * 2;
constexpr size_t OFF_YM   = OFF_QR + (size_t)8 * SEQ * 64 * 2;
constexpr size_t OFF_KP8  = OFF_YM + (size_t)SEQ * 1024 * 2;
constexpr size_t OFF_BAR  = OFF_KP8 + (size_t)(LP / 64) * 4096;
constexpr size_t BAR_BYTES = 16384;
constexpr size_t WS_END   = OFF_BAR + BAR_BYTES;
constexpr size_t OFF_K8   = OFF_V + (size_t)8 * (LP / 64) * 8192;
constexpr size_t OFF_HB   = OFF_X;
constexpr size_t OFF_WIN  = OFF_HB + (size_t)LP * 1024 * 2;
constexpr size_t OFF_LAT  = OFF_YM;
static_assert(OFF_WIN + (size_t)NPROJ_P * 1024 * 2 <= OFF_YM, "Hb/WinT must not overlap LAT");
static_assert(OFF_LAT + (size_t)LP * 512 * 2 <= WS_END, "LAT fits");
static_assert(WS_END <= (size_t)256 * 1024 * 1024, "workspace fits 256 MiB");

struct Params {
  const float *x, *meta, *norm_w, *w_in, *qlw, *kvlw, *w_uq, *w_ukv, *qn_w, *qpe_w, *kn_w, *kpe_w, *naq_w, *nak_w, *relb, *metab, *w_out;
  float* out;
  unsigned char* ws;
  int tid0;
  int pad_;
};

DEVINL int tidx(const Params& p) { int l; asm volatile("v_mbcnt_lo_u32_b32 %0, -1, 0\n\tv_mbcnt_hi_u32_b32 %0, -1, %0" : "=v"(l)); return p.tid0 + l; }
DEVINL unsigned char* wsp(const Params& p) { unsigned char* w = p.ws; asm volatile("" : "+s"(w)); return w; }
DEVINL unsigned cvtpk(float lo, float hi) { unsigned r; asm("v_cvt_pk_bf16_f32 %0, %1, %2" : "=v"(r) : "v"(lo), "v"(hi)); return r; }
DEVINL unsigned cvtpk_v(float lo, float hi) { unsigned r; asm volatile("v_cvt_pk_bf16_f32 %0, %1, %2" : "=v"(r) : "v"(lo), "v"(hi)); return r; }
DEVINL int pk8(float a, float b, float c, float d) { int w = 0; w = __builtin_amdgcn_cvt_pk_fp8_f32(a, b, w, false); w = __builtin_amdgcn_cvt_pk_fp8_f32(c, d, w, true); return w; }
using i32x6 = __attribute__((ext_vector_type(6))) int;
DEVINL i32x6 pk6(const f32x16& a, const f32x16& b) { return __builtin_amdgcn_cvt_scalef32_2xpk16_fp6_f32(a, b, 1.0f); }
DEVINL float bf2f(unsigned short u) { return __uint_as_float(((unsigned)u) << 16); }
DEVINL float bflo(unsigned u) { return __uint_as_float(u << 16); }
DEVINL float bfhi(unsigned u) { return __uint_as_float(u & 0xffff0000u); }
DEVINL int crow(int r, int hi) { return (r & 3) + 8 * (r >> 2) + 4 * hi; }
DEVINL float silu(float v) { return v / (1.f + __expf(-v)); }
#define SBAR() __builtin_amdgcn_sched_barrier(0)
DEVINL int v_st(int k, int c) { const int kk = (k & ~0xC) | ((k & 4) << 1) | ((k & 8) >> 1); return ((kk >> 3) * 4 + (c >> 5)) * 512 + ((kk & 7) * 32 + (c & 31)) * 2; }

DEVINL void tr_tile(const Params& p, const float* __restrict__ src, int sld, int sc0, int k0, const float* __restrict__ scale, bf16_t* __restrict__ dst, int dld, int n0, float* tile) {
  const int tid = tidx(p);
  __syncthreads();
  {
    const int kk = tid >> 4, nn = (tid & 15) * 4;
#pragma unroll
    for (int i = 0; i < 2; ++i) {
      const int k = kk + i * 32;
      float4 v = make_float4(0.f, 0.f, 0.f, 0.f);
      if (sc0 >= 0) {
        v = *reinterpret_cast<const float4*>(src + (size_t)(k0 + k) * sld + sc0 + nn);
        const float s = scale ? scale[k0 + k] : 1.f;
        v.x *= s; v.y *= s; v.z *= s; v.w *= s;
      }
      tile[k * 65 + nn + 0] = v.x; tile[k * 65 + nn + 1] = v.y; tile[k * 65 + nn + 2] = v.z; tile[k * 65 + nn + 3] = v.w;
    }
  }
  __syncthreads();
  {
    const int n = tid >> 3, kc = (tid & 7) * 8;
    float f[8];
#pragma unroll
    for (int j = 0; j < 8; ++j) f[j] = tile[(kc + j) * 65 + n];
    u32x4 w = {cvtpk(f[0], f[1]), cvtpk(f[2], f[3]), cvtpk(f[4], f[5]), cvtpk(f[6], f[7])};
    *reinterpret_cast<u32x4*>(dst + (size_t)(n0 + n) * dld + k0 + kc) = w;
  }
}

DEVINL void phase_prep(const Params& p, char* lds) {
  const int tid = tidx(p), wave = tid >> 6, lane = tid & 63;
  bf16_t* Hb = (bf16_t*)(wsp(p) + OFF_HB);
  float* r1 = (float*)(wsp(p) + OFF_R1);
  for (int row = blockIdx.x * 8 + wave; row < LP; row += gridDim.x * 8) {
    bf16_t* dst = Hb + (size_t)row * DM;
    if (row < L) {
      const float* src = row < NMETA ? p.meta + (size_t)row * DM : p.x + (size_t)(row - NMETA) * DM;
      float ss = 0.f;
#pragma unroll
      for (int i = 0; i < 4; ++i) {
        float4 v = *reinterpret_cast<const float4*>(src + (lane + 64 * i) * 4);
        ss += v.x * v.x + v.y * v.y + v.z * v.z + v.w * v.w;
        u32x2 w = {cvtpk(v.x, v.y), cvtpk(v.z, v.w)};
        *reinterpret_cast<u32x2*>(dst + (lane + 64 * i) * 4) = w;
      }
#pragma unroll
      for (int o = 32; o >= 1; o >>= 1) ss += __shfl_xor(ss, o);
      if (lane == 0) r1[row] = rsqrtf(ss * (1.f / DM) + EPS);
    } else {
#pragma unroll
      for (int i = 0; i < 4; ++i) { u32x2 w = {0u, 0u}; *reinterpret_cast<u32x2*>(dst + (lane + 64 * i) * 4) = w; }
      if (lane == 0) r1[row] = 0.f;
    }
  }
  float* tile = (float*)lds;
  bf16_t* WinT = (bf16_t*)(wsp(p) + OFF_WIN); bf16_t* WuqT = (bf16_t*)(wsp(p) + OFF_WUQ);
  bf16_t* WukvT = (bf16_t*)(wsp(p) + OFF_WUKV); bf16_t* WoutT = (bf16_t*)(wsp(p) + OFF_WOUT);
  constexpr int J_IN = 92 * 16, J_UQ = 24 * 4, J_UKV = 32 * 4, J_OUT = 16 * 32;
  for (int j = blockIdx.x; j < J_IN + J_UQ + J_UKV + J_OUT; j += gridDim.x) {
    if (j < J_IN) {
      const int nb = j >> 4, kb = j & 15, n0 = nb * 64;
      int sc0;
      if (n0 < 512) sc0 = n0;
      else if (n0 < 1536) sc0 = n0 - 512 + 576;
      else if (n0 < 2560) sc0 = n0 - 1536 + 1600;
      else if (n0 < 3584) sc0 = n0 - 2560 + 2624;
      else if (n0 < 4608) sc0 = n0 - 3584 + 3648;
      else if (n0 < 5632) sc0 = n0 - 4608 + 4672;
      else if (n0 < 5696) sc0 = 512;
      else sc0 = -1;
      tr_tile(p, p.w_in, NPROJ, sc0, kb * 64, p.norm_w, WinT, DM, n0, tile);
    } else if (j < J_IN + J_UQ) {
      const int jj = j - J_IN, nb = jj >> 2, kb = jj & 3;
      const int sc0 = nb < 16 ? (nb >> 1) * 192 + (nb & 1) * 64 : (nb - 16) * 192 + 128;
      tr_tile(p, p.w_uq, 1536, sc0, kb * 64, p.qlw, WuqT, QR, nb * 64, tile);
    } else if (j < J_IN + J_UQ + J_UKV) {
      const int jj = j - J_IN - J_UQ, nb = jj >> 2, kb = jj & 3;
      const int sc0 = nb < 16 ? (nb >> 1) * 256 + (nb & 1) * 64 : ((nb - 16) >> 1) * 256 + 128 + ((nb - 16) & 1) * 64;
      tr_tile(p, p.w_ukv, 2048, sc0, kb * 64, p.kvlw, WukvT, KVR, nb * 64, tile);
    } else {
      const int jj = j - J_IN - J_UQ - J_UKV, nb = jj >> 5, kb = jj & 31;
      tr_tile(p, p.w_out, DM, nb * 64, kb * 64, nullptr, WoutT, 2048, nb * 64, tile);
    }
  }
}

constexpr int BK = 64, HALF = 128, HT = HALF * BK;
DEVINL int lds_byte(int r, int c) {
  int st = (r >> 4) * 2 + (c >> 5), rr = r & 15, cc = c & 31, ob = rr * 64 + cc * 2;
  return st * 1024 + (ob ^ (((ob >> 9) & 1) << 5));
}
DEVINL void stage_rc(int b, int& R, int& C) {
  int st = b / 1024, sb = b % 1024, swz = sb ^ (((sb >> 9) & 1) << 5);
  R = (st >> 1) * 16 + swz / 64; C = (st & 1) * 32 + (swz % 64) / 2;
}

template <bool SWAP, class Epi>
DEVINL void gemm_tile(const Params& p, const bf16_t* __restrict__ A0, const bf16_t* __restrict__ A1, int ksplit, int lda,
                      const bf16_t* __restrict__ Bt, int ldb, int nt, char* shmc, Epi epi) {
  bf16_t* shm = (bf16_t*)shmc;
#define SA(b, h) (shm + ((b) * 2 + (h)) * HT)
#define SB(b, h) (shm + (4 + (b) * 2 + (h)) * HT)
#define APTR(kt) (((kt) < ksplit ? A0 + (size_t)(kt) * BK : A1 + (size_t)((kt) - ksplit) * BK))
#define STAGE_A(P, hh, kt) do { const bf16_t* _base = APTR(kt) + (size_t)(hh) * HALF * lda; \
    __builtin_amdgcn_global_load_lds((const unsigned*)(_base + offA0), (__attribute__((address_space(3))) unsigned*)((char*)(P) + tid16), 16, 0, 0); \
    __builtin_amdgcn_global_load_lds((const unsigned*)(_base + offA1), (__attribute__((address_space(3))) unsigned*)((char*)(P) + tid16 + 8192), 16, 0, 0); } while (0)
#define STAGE_B(P, hh, kt) do { const bf16_t* _base = Bt + (size_t)(hh) * HALF * ldb + (size_t)(kt) * BK; \
    __builtin_amdgcn_global_load_lds((const unsigned*)(_base + offB0), (__attribute__((address_space(3))) unsigned*)((char*)(P) + tid16), 16, 0, 0); \
    __builtin_amdgcn_global_load_lds((const unsigned*)(_base + offB1), (__attribute__((address_space(3))) unsigned*)((char*)(P) + tid16 + 8192), 16, 0, 0); } while (0)
#define LDA(dst, b, h) for (int m = 0; m < 4; ++m) for (int k = 0; k < 2; ++k) \
    dst[m][k] = *reinterpret_cast<const bf16x8*>((char*)SA(b, h) + lds_byte(wr * 64 + m * 16 + fr, k * 32 + fq * 8))
#define LDB(dst, b, h) for (int n = 0; n < 2; ++n) for (int k = 0; k < 2; ++k) \
    dst[n][k] = *reinterpret_cast<const bf16x8*>((char*)SB(b, h) + lds_byte(wc * 32 + n * 16 + fr, k * 32 + fq * 8))
#define MMA(ai, bj, At, Bt_) do { __builtin_amdgcn_s_setprio(1); \
    for (int m = 0; m < 4; ++m) for (int n = 0; n < 2; ++n) for (int k = 0; k < 2; ++k) { \
      if (SWAP) acc[ai][bj][m][n] = __builtin_amdgcn_mfma_f32_16x16x32_bf16(Bt_[n][k], At[m][k], acc[ai][bj][m][n], 0, 0, 0); \
      else      acc[ai][bj][m][n] = __builtin_amdgcn_mfma_f32_16x16x32_bf16(At[m][k], Bt_[n][k], acc[ai][bj][m][n], 0, 0, 0); } \
    __builtin_amdgcn_s_setprio(0); } while (0)
#define WAIT_V(n) asm volatile("s_waitcnt vmcnt(" #n ")" ::: "memory")
#define WAIT_L(n) asm volatile("s_waitcnt lgkmcnt(" #n ")" ::: "memory")
#define BAR __builtin_amdgcn_s_barrier()
#define SCHED __builtin_amdgcn_sched_barrier(0)
  const int tid = tidx(p), tid16 = tid * 16;
  int R0, C0, R1, C1; stage_rc(tid16, R0, C0); stage_rc(tid16 + 8192, R1, C1);
  const size_t offA0 = (size_t)R0 * lda + C0, offA1 = (size_t)R1 * lda + C1;
  const size_t offB0 = (size_t)R0 * ldb + C0, offB1 = (size_t)R1 * ldb + C1;
  const int wid = tid >> 6, lane = tid & 63, wr = wid >> 2, wc = wid & 3, fr = lane & 15, fq = lane >> 4;
  f32x4 acc[2][2][4][2] = {};
  bf16x8 At[4][2], B0[2][2], B1[2][2];
  WAIT_V(0);
  STAGE_B(SB(0, 0), 0, 0); STAGE_A(SA(0, 0), 0, 0);
  STAGE_B(SB(0, 1), 1, 0); STAGE_A(SA(0, 1), 1, 0);
  if (wr == 1) BAR;
  WAIT_V(4); BAR;
  STAGE_B(SB(1, 0), 0, 1); STAGE_A(SA(1, 0), 0, 1); STAGE_B(SB(1, 1), 1, 1);
  WAIT_V(6); BAR;
  for (int t = 0; t < nt - 2; t += 2) {
    LDB(B0, 0, 0); SCHED; LDA(At, 0, 0); STAGE_A(SA(1, 1), 1, t + 1);
    WAIT_L(8); BAR; WAIT_L(0); MMA(0, 0, At, B0); BAR; SCHED;
    LDB(B1, 0, 1); STAGE_B(SB(0, 0), 0, t + 2);
    BAR; WAIT_L(0); MMA(0, 1, At, B1); BAR;
    LDA(At, 0, 1); STAGE_A(SA(0, 0), 0, t + 2);
    BAR; WAIT_L(0); MMA(1, 0, At, B0); BAR; SCHED;
    STAGE_B(SB(0, 1), 1, t + 2);
    WAIT_V(6); BAR; MMA(1, 1, At, B1); BAR;
    LDB(B0, 1, 0); SCHED; LDA(At, 1, 0); STAGE_A(SA(0, 1), 1, t + 2);
    WAIT_L(8); BAR; WAIT_L(0); MMA(0, 0, At, B0); BAR; SCHED;
    LDB(B1, 1, 1); STAGE_B(SB(1, 0), 0, t + 3);
    BAR; WAIT_L(0); MMA(0, 1, At, B1); BAR;
    LDA(At, 1, 1); STAGE_A(SA(1, 0), 0, t + 3);
    BAR; WAIT_L(0); MMA(1, 0, At, B0); BAR; SCHED;
    STAGE_B(SB(1, 1), 1, t + 3);
    WAIT_V(6); BAR; MMA(1, 1, At, B1); BAR;
  }
  { LDB(B0, 0, 0); LDA(At, 0, 0); STAGE_A(SA(1, 1), 1, nt - 1);
    BAR; WAIT_L(0); MMA(0, 0, At, B0); BAR;
    LDB(B1, 0, 1); BAR; WAIT_L(0); MMA(0, 1, At, B1); BAR;
    LDA(At, 0, 1); WAIT_V(4); BAR; WAIT_L(0); MMA(1, 0, At, B0); MMA(1, 1, At, B1); BAR; }
  { LDB(B0, 1, 0); LDA(At, 1, 0); WAIT_V(2); BAR; WAIT_L(0); MMA(0, 0, At, B0); BAR;
    LDB(B1, 1, 1); WAIT_V(0); BAR; WAIT_L(0); MMA(0, 1, At, B1); BAR;
    LDA(At, 1, 1); BAR; WAIT_L(0); MMA(1, 0, At, B0); MMA(1, 1, At, B1); BAR; }
  if (wr == 0) BAR;
#pragma unroll
  for (int ai = 0; ai < 2; ++ai)
#pragma unroll
    for (int bj = 0; bj < 2; ++bj)
#pragma unroll
      for (int m = 0; m < 4; ++m)
#pragma unroll
        for (int n = 0; n < 2; ++n) {
          if (SWAP) epi(ai * HALF + wr * 64 + m * 16 + fr, bj * HALF + wc * 32 + n * 16 + fq * 4, acc[ai][bj][m][n]);
          else      epi(ai * HALF + wr * 64 + m * 16 + fq * 4, bj * HALF + wc * 32 + n * 16 + fr, acc[ai][bj][m][n]);
        }
#undef SA
#undef SB
#undef APTR
#undef STAGE_A
#undef STAGE_B
#undef LDA
#undef LDB
#undef MMA
}

DEVINL void knorm_image(const Params& p, int ht, int lanen) {
  const bf16_t* KN = (const bf16_t*)(wsp(p) + OFF_KN); char* K8 = (char*)(wsp(p) + OFF_K8);
  const bf16_t* src = KN + (size_t)ht * 8192 + lanen * 8;
  u32x4 raw[16];
#pragma unroll
  for (int kc = 0; kc < 16; ++kc) raw[kc] = *reinterpret_cast<const u32x4*>(src + kc * 512);
  float ss = 0.f;
#pragma unroll
  for (int kc = 0; kc < 16; ++kc)
#pragma unroll
    for (int j = 0; j < 4; ++j) { const float a = bflo(raw[kc][j]), b = bfhi(raw[kc][j]); ss += a * a + b * b; }
  const float r = rsqrtf(ss * (1.f / 128.f) + EPS);
  char* dst = K8 + (size_t)ht * 6144;
#pragma unroll
  for (int c = 0; c < 4; ++c) {
    f32x16 a, b;
#pragma unroll
    for (int q = 0; q < 2; ++q)
#pragma unroll
      for (int j = 0; j < 4; ++j) {
        const int kca = c * 4 + q, kcb = c * 4 + 2 + q, da = kca * 8 + 2 * j, db = kcb * 8 + 2 * j;
        a[q * 8 + 2 * j] = bflo(raw[kca][j]) * r * p.kn_w[da]; a[q * 8 + 2 * j + 1] = bfhi(raw[kca][j]) * r * p.kn_w[da + 1];
        b[q * 8 + 2 * j] = bflo(raw[kcb][j]) * r * p.kn_w[db]; b[q * 8 + 2 * j + 1] = bfhi(raw[kcb][j]) * r * p.kn_w[db + 1];
      }
    const i32x6 w = pk6(a, b);
    u32x4 wa = {(unsigned)w[0], (unsigned)w[1], (unsigned)w[2], (unsigned)w[3]}; u32x2 wb = {(unsigned)w[4], (unsigned)w[5]};
    *reinterpret_cast<u32x4*>(dst + c * 1024 + lanen * 16) = wa;
    *reinterpret_cast<u32x2*>(dst + 4096 + c * 512 + lanen * 8) = wb;
  }
}
DEVINL void kpe_image(const Params& p, int tile, int lanen) {
  const bf16_t* KPE = (const bf16_t*)(wsp(p) + OFF_KPE); char* KP8 = (char*)(wsp(p) + OFF_KP8);
  const bf16_t* src = KPE + (size_t)tile * 4096 + lanen * 8;
  float f[64];
#pragma unroll
  for (int kc = 0; kc < 8; ++kc) { const u32x4 w = *reinterpret_cast<const u32x4*>(src + kc * 512);
#pragma unroll
    for (int j = 0; j < 4; ++j) { f[kc * 8 + 2 * j] = bflo(w[j]); f[kc * 8 + 2 * j + 1] = bfhi(w[j]); } }
  float ss = 0.f;
#pragma unroll
  for (int d = 0; d < 64; ++d) ss += f[d] * f[d];
  const float r = rsqrtf(ss * (1.f / 64.f) + EPS);
  const float pos = (float)(tile * 64 + lanen);
  f32x16 a0, b0, a1, b1;
#pragma unroll
  for (int i = 0; i < 32; ++i) {
    const float x1 = f[i] * r * p.kpe_w[i], x2 = f[i + 32] * r * p.kpe_w[i + 32];
    const float invf = exp2f(-(float)i * (13.287712379549449f / 32.f));
    const float ang = pos * invf;
    const float k = rintf(ang * 0.15915494309189535f);
    float rr = fmaf(-k, 6.2831855f, ang); rr = fmaf(-k, -1.7484555e-7f, rr);
    const float c = __cosf(rr), s = __sinf(rr);
    const float y1 = x1 * c - x2 * s, y2 = x2 * c + x1 * s;
    if (i < 16) { a0[i] = y1; a1[i] = y2; } else { b0[i - 16] = y1; b1[i - 16] = y2; }
  }
  char* dst = KP8 + (size_t)tile * 3072;
  const i32x6 w0 = pk6(a0, b0), w1 = pk6(a1, b1);
  u32x4 wa0 = {(unsigned)w0[0], (unsigned)w0[1], (unsigned)w0[2], (unsigned)w0[3]}, wa1 = {(unsigned)w1[0], (unsigned)w1[1], (unsigned)w1[2], (unsigned)w1[3]};
  u32x2 wb0 = {(unsigned)w0[4], (unsigned)w0[5]}, wb1 = {(unsigned)w1[4], (unsigned)w1[5]};
  *reinterpret_cast<u32x4*>(dst + lanen * 16) = wa0; *reinterpret_cast<u32x4*>(dst + 1024 + lanen * 16) = wa1;
  *reinterpret_cast<u32x2*>(dst + 2048 + lanen * 8) = wb0; *reinterpret_cast<u32x2*>(dst + 2048 + 512 + lanen * 8) = wb1;
}
DEVINL void nak_group(const Params& p, int t, int h) {
  bf16_t* NAK = (bf16_t*)(wsp(p) + OFF_NAK);
  const int blk = t < NMETA ? 0 : 1 + ((t - NMETA) >> 5), r32 = t < NMETA ? t : ((t - NMETA) & 31);
  bf16_t* base = NAK + (size_t)(h * 513 + blk) * 2048 + r32 * 8;
  u32x4 raw[8];
#pragma unroll
  for (int pc = 0; pc < 8; ++pc) raw[pc] = *reinterpret_cast<const u32x4*>(base + pc * 256);
  float ss = 0.f;
#pragma unroll
  for (int pc = 0; pc < 8; ++pc)
#pragma unroll
    for (int j = 0; j < 4; ++j) { const float a = bflo(raw[pc][j]), b = bfhi(raw[pc][j]); ss += a * a + b * b; }
  const float r = rsqrtf(ss * (1.f / 64.f) + EPS);
#pragma unroll
  for (int pc = 0; pc < 8; ++pc) {
    u32x4 o;
#pragma unroll
    for (int j = 0; j < 4; ++j) { const int d = pc * 8 + j * 2; o[j] = cvtpk(bflo(raw[pc][j]) * r * p.nak_w[d], bfhi(raw[pc][j]) * r * p.nak_w[d + 1]); }
    *reinterpret_cast<u32x4*>(base + pc * 256) = o;
  }
}

DEVINL void qn_row(const Params& p, bf16_t* rowp) {
  u32x4 raw[16];
#pragma unroll
  for (int c = 0; c < 16; ++c) raw[c] = *reinterpret_cast<const u32x4*>(rowp + c * 8);
  float ss = 0.f;
#pragma unroll
  for (int c = 0; c < 16; ++c)
#pragma unroll
    for (int j = 0; j < 4; ++j) { const float a = bflo(raw[c][j]), b = bfhi(raw[c][j]); ss += a * a + b * b; }
  const float r = rsqrtf(ss * (1.f / 128.f) + EPS);
#pragma unroll
  for (int ch = 0; ch < 4; ++ch) {
    f32x16 a, b;
#pragma unroll
    for (int q = 0; q < 2; ++q)
#pragma unroll
      for (int j = 0; j < 4; ++j) {
        const int ca = ch * 4 + q, cb = ch * 4 + 2 + q, da = ca * 8 + 2 * j, db = cb * 8 + 2 * j;
        a[q * 8 + 2 * j] = bflo(raw[ca][j]) * r * p.qn_w[da]; a[q * 8 + 2 * j + 1] = bfhi(raw[ca][j]) * r * p.qn_w[da + 1];
        b[q * 8 + 2 * j] = bflo(raw[cb][j]) * r * p.qn_w[db]; b[q * 8 + 2 * j + 1] = bfhi(raw[cb][j]) * r * p.qn_w[db + 1];
      }
    const i32x6 w = pk6(a, b);
    u32x2* d = reinterpret_cast<u32x2*>((char*)rowp + ch * 24);
    d[0] = u32x2{(unsigned)w[0], (unsigned)w[1]}; d[1] = u32x2{(unsigned)w[2], (unsigned)w[3]}; d[2] = u32x2{(unsigned)w[4], (unsigned)w[5]};
  }
}
DEVINL void qr_row(const Params& p, bf16_t* rowp, int posi) {
  float f[64];
#pragma unroll
  for (int c = 0; c < 8; ++c) { const u32x4 w = *reinterpret_cast<const u32x4*>(rowp + c * 8);
#pragma unroll
    for (int j = 0; j < 4; ++j) { f[c * 8 + 2 * j] = bflo(w[j]); f[c * 8 + 2 * j + 1] = bfhi(w[j]); } }
  float ss = 0.f;
#pragma unroll
  for (int d = 0; d < 64; ++d) ss += f[d] * f[d];
  const float r = rsqrtf(ss * (1.f / 64.f) + EPS);
  const float pos = (float)posi;
  f32x16 a0, b0, a1, b1;
#pragma unroll
  for (int i = 0; i < 32; ++i) {
    const float x1 = f[i] * r * p.qpe_w[i], x2 = f[i + 32] * r * p.qpe_w[i + 32];
    const float invf = exp2f(-(float)i * (13.287712379549449f / 32.f));
    const float ang = pos * invf;
    const float k = rintf(ang * 0.15915494309189535f);
    float rr = fmaf(-k, 6.2831855f, ang); rr = fmaf(-k, -1.7484555e-7f, rr);
    const float c = __cosf(rr), s = __sinf(rr);
    const float y1 = x1 * c - x2 * s, y2 = x2 * c + x1 * s;
    if (i < 16) { a0[i] = y1; a1[i] = y2; } else { b0[i - 16] = y1; b1[i - 16] = y2; }
  }
  const i32x6 w0 = pk6(a0, b0), w1 = pk6(a1, b1);
  u32x2* d = reinterpret_cast<u32x2*>(rowp);
  d[0] = u32x2{(unsigned)w0[0], (unsigned)w0[1]}; d[1] = u32x2{(unsigned)w0[2], (unsigned)w0[3]}; d[2] = u32x2{(unsigned)w0[4], (unsigned)w0[5]};
  d[3] = u32x2{(unsigned)w1[0], (unsigned)w1[1]}; d[4] = u32x2{(unsigned)w1[2], (unsigned)w1[3]}; d[5] = u32x2{(unsigned)w1[4], (unsigned)w1[5]};
}

DEVINL void phase_gemm1(const Params& p, char* lds) {
  const bf16_t* Hb = (const bf16_t*)(wsp(p) + OFF_HB); const bf16_t* WinT = (const bf16_t*)(wsp(p) + OFF_WIN);
  const float* r1 = (const float*)(wsp(p) + OFF_R1);
  bf16_t* LAT = (bf16_t*)(wsp(p) + OFF_LAT); bf16_t* KPE = (bf16_t*)(wsp(p) + OFF_KPE);
  bf16_t* NAQ = (bf16_t*)(wsp(p) + OFF_NAQ); bf16_t* NAK = (bf16_t*)(wsp(p) + OFF_NAK); bf16_t* VT = (bf16_t*)(wsp(p) + OFF_VT);
  bf16_t* G = (bf16_t*)p.out;
  constexpr int NM = LP / 256, NN = NPROJ_P / 256;
  constexpr int NT1 = NM * NN, PER_XCD = (NT1 + 7) / 8;
  const int xcd = blockIdx.x & 7, bix = blockIdx.x >> 3, nbx = gridDim.x >> 3;
  for (int i = bix; i < PER_XCD; i += nbx) {
    const int u = xcd * PER_XCD + i;
    if (u >= NT1) break;
    int pm, pn;
    { constexpr int FULL = (NN / 4) * 4 * NM;
      if (u < FULL) { const int s = u / (4 * NM), w = u - s * 4 * NM; pm = w >> 2; pn = s * 4 + (w & 3); }
      else { constexpr int REM = NN - (NN / 4) * 4; const int w = u - FULL; pm = w / REM; pn = (NN / 4) * 4 + (w - pm * REM); } }
    const int brow = pm * 256;
    const bf16_t* A = Hb + (size_t)brow * DM; const bf16_t* B = WinT + (size_t)pn * 256 * DM;
    if (pn >= 14 && pn < 18) {
      const float* rr = r1 + brow;
      gemm_tile<false>(p, A, A, 1 << 30, DM, B, DM, DM / BK, lds, [=](int row, int col, f32x4 v) {
        const int t = brow + row;
        if (t < L) {
          const f32x4 s = *reinterpret_cast<const f32x4*>(rr + row);
          u32x2 w = {cvtpk(v[0] * s[0], v[1] * s[1]), cvtpk(v[2] * s[2], v[3] * s[3])};
          const int cg_ = (pn - 14) * 256 + col, h = cg_ >> 6, db = (cg_ >> 5) & 1, c32 = cg_ & 31;
          const int kb = t < NMETA ? 0 : 1 + ((t - NMETA) >> 4), kin = t < NMETA ? t : ((t - NMETA) & 15);
          *reinterpret_cast<u32x2*>(VT + ((size_t)((h * 1025 + kb) * 2 + db) * 64 + (kin >> 3) * 32 + c32) * 8 + (kin & 7)) = w;
        }
      });
    } else if (pn == 22) {
      gemm_tile<true>(p, A, A, 1 << 30, DM, B, DM, DM / BK, lds, [=](int row, int col, f32x4 v) {
        const int t = brow + row;
        if (col < 64) {
          const float s = r1[t];
          u32x2 w = {cvtpk(v[0] * s, v[1] * s), cvtpk(v[2] * s, v[3] * s)};
          *reinterpret_cast<u32x2*>(KPE + ((size_t)((t >> 6) * 8 + (col >> 3)) * 64 + (t & 63)) * 8 + (col & 7)) = w;
        }
      });
      asm volatile("s_waitcnt vmcnt(0)" ::: "memory"); __syncthreads();
      { const int tid = tidx(p), w = tid >> 6; if (w < 4) kpe_image(p, pm * 4 + w, tid & 63); }
    } else if (pn >= 10 && pn < 14) {
      gemm_tile<true>(p, A, A, 1 << 30, DM, B, DM, DM / BK, lds, [=](int row, int col, f32x4 v) {
        const int t = brow + row;
        if (t < L) {
          const float s = r1[t];
          u32x2 w = {cvtpk(v[0] * s, v[1] * s), cvtpk(v[2] * s, v[3] * s)};
          const int cg_ = (pn - 10) * 256 + col, h = cg_ >> 6, d = cg_ & 63;
          const int blk = t < NMETA ? 0 : 1 + ((t - NMETA) >> 5), r32 = t < NMETA ? t : ((t - NMETA) & 31);
          *reinterpret_cast<u32x2*>(NAK + ((size_t)((h * 513 + blk) * 4 + (d >> 4)) * 64 + ((d >> 3) & 1) * 32 + r32) * 8 + (d & 7)) = w;
        }
      });
      asm volatile("s_waitcnt vmcnt(0)" ::: "memory"); __syncthreads();
      { const int tid = tidx(p), t = brow + (tid & 255);
        if (t < L) { const int h0 = (pn - 10) * 4 + (tid >> 8) * 2; nak_group(p, t, h0); nak_group(p, t, h0 + 1); } }
    } else {
      bf16_t* dst; int ld, rlo = 0, rhi = LP, roff = 0, climit = 256; bool do_silu = false;
      if (pn < 2)        { dst = LAT + pn * 256; ld = 512; }
      else if (pn < 6)   { dst = G + (pn - 2) * 256; ld = 1024; rlo = NMETA; rhi = L; roff = NMETA; do_silu = true; }
      else if (pn < 10)  { dst = NAQ + (pn - 6) * 256; ld = 1024; }
      else if (pn < 22)  { dst = G + (size_t)SEQ * 1024 + (pn - 18) * 256; ld = 1024; rlo = NMETA; rhi = L; roff = NMETA; do_silu = true; }
      else               { dst = KPE; ld = 64; climit = 64; }
      gemm_tile<true>(p, A, A, 1 << 30, DM, B, DM, DM / BK, lds, [=](int row, int col, f32x4 v) {
        const int grow = brow + row;
        if (grow >= rlo && grow < rhi && col < climit) {
          const float s = r1[grow];
          float a = v[0] * s, b = v[1] * s, c = v[2] * s, d = v[3] * s;
          if (do_silu) { a = silu(a); b = silu(b); c = silu(c); d = silu(d); }
          u32x2 w = {cvtpk(a, b), cvtpk(c, d)};
          *reinterpret_cast<u32x2*>(dst + (size_t)(grow - roff) * ld + col) = w;
        }
      });
    }
  }
}

DEVINL void phase_gemm2(const Params& p, char* lds) {
  const bf16_t* LAT = (const bf16_t*)(wsp(p) + OFF_LAT);
  const bf16_t* WuqT = (const bf16_t*)(wsp(p) + OFF_WUQ); const bf16_t* WukvT = (const bf16_t*)(wsp(p) + OFF_WUKV);
  bf16_t* KN = (bf16_t*)(wsp(p) + OFF_KN); bf16_t* V = (bf16_t*)(wsp(p) + OFF_V);
  bf16_t* QN = (bf16_t*)(wsp(p) + OFF_QN); bf16_t* QRp = (bf16_t*)(wsp(p) + OFF_QR);
  float* rs = (float*)(lds + 131072);
  constexpr int T_KV = (LP / 256) * 8, T_Q = (SEQ / 256) * 6;
  const int xcd2 = blockIdx.x & 7, bix2 = blockIdx.x >> 3, nbx2 = gridDim.x >> 3;
  for (int k2 = 0; ; ++k2) {
    const int t = (k2 * 8 + xcd2) * nbx2 + bix2;
    if (t >= T_KV + T_Q) break;
    const bool iskv = t < T_KV;
    int pm, pn; const bf16_t* A;
    if (iskv) { pm = t >> 3; pn = t & 7; A = LAT + (size_t)pm * 256 * 512 + 256; }
    else { const int tt = t - T_KV; pm = tt / 6; pn = tt - pm * 6; A = LAT + (size_t)(pm * 256 + NMETA) * 512; }
    __syncthreads();
    {
      const int row = tidx(p) >> 1, half = tidx(p) & 1;
      const bf16_t* src = A + (size_t)row * 512 + half * 128;
      float ss = 0.f;
#pragma unroll
      for (int i = 0; i < 16; ++i) {
        u32x4 w = *reinterpret_cast<const u32x4*>(src + i * 8);
#pragma unroll
        for (int j = 0; j < 4; ++j) { float a = bflo(w[j]), b = bfhi(w[j]); ss += a * a + b * b; }
      }
      ss += __shfl_xor(ss, 1);
      if (half == 0) rs[row] = rsqrtf(ss * (1.f / 256.f) + EPS);
    }
    __syncthreads();
    const int grow0 = pm * 256;
    if (iskv && pn < 4) {
      gemm_tile<true>(p, A, A, 1 << 30, 512, WukvT + (size_t)pn * 256 * KVR, KVR, KVR / BK, lds, [=](int row, int col, f32x4 v) {
        const float s = rs[row];
        u32x2 w = {cvtpk(v[0] * s, v[1] * s), cvtpk(v[2] * s, v[3] * s)};
        const int t = grow0 + row, tile = t >> 6, k = t & 63, h = pn * 2 + (col >> 7), d = col & 127;
        *reinterpret_cast<u32x2*>(KN + (size_t)h * LP * 128 + ((size_t)(tile * 16 + (d >> 3)) * 64 + k) * 8 + (d & 7)) = w;
      });
      asm volatile("s_waitcnt vmcnt(0)" ::: "memory"); __syncthreads();
      { const int tid = tidx(p), w = tid >> 6; knorm_image(p, (pn * 2 + (w >> 2)) * (LP / 64) + pm * 4 + (w & 3), tid & 63); }
    } else if (iskv) {
      char* V8 = (char*)(wsp(p) + OFF_V);
      gemm_tile<false>(p, A, A, 1 << 30, 512, WukvT + (size_t)pn * 256 * KVR, KVR, KVR / BK, lds, [=](int row, int col, f32x4 v) {
        const int t = grow0 + row, tile = t >> 6, k = t & 63, h = (pn - 4) * 2 + (col >> 7), d = col & 127;
        const int w = pk8(v[0] * rs[row], v[1] * rs[row + 1], v[2] * rs[row + 2], v[3] * rs[row + 3]);
        const int half = k >> 5, g = (k & 31) >> 3, khi = (k >> 2) & 1;
        *reinterpret_cast<int*>(V8 + ((size_t)(h * (LP / 64) + tile)) * 8192 + (((((d >> 5) * 2 + khi) * 2 + half) * 32 + (d & 31)) * 16 + 4 * g)) = w;
      });
    } else if (pn < 4) {
      gemm_tile<true>(p, A, A, 1 << 30, 512, WuqT + (size_t)pn * 256 * QR, QR, QR / BK, lds, [=](int row, int col, f32x4 v) {
        const float s = rs[row];
        u32x2 w = {cvtpk(v[0] * s, v[1] * s), cvtpk(v[2] * s, v[3] * s)};
        const int n = pn * 256 + col, h = n >> 7, d = n & 127;
        *reinterpret_cast<u32x2*>(QN + ((size_t)h * SEQ + grow0 + row) * 128 + d) = w;
      });
      asm volatile("s_waitcnt vmcnt(0)" ::: "memory"); __syncthreads();
      { const int tid = tidx(p); qn_row(p, QN + ((size_t)(pn * 2 + (tid >> 8)) * SEQ + grow0 + (tid & 255)) * 128); }
    } else {
      gemm_tile<true>(p, A, A, 1 << 30, 512, WuqT + (size_t)pn * 256 * QR, QR, QR / BK, lds, [=](int row, int col, f32x4 v) {
        const float s = rs[row];
        u32x2 w = {cvtpk(v[0] * s, v[1] * s), cvtpk(v[2] * s, v[3] * s)};
        const int n = (pn - 4) * 256 + col, h = n >> 6, d = n & 63;
        *reinterpret_cast<u32x2*>(QRp + ((size_t)h * SEQ + grow0 + row) * 64 + d) = w;
      });
      asm volatile("s_waitcnt vmcnt(0)" ::: "memory"); __syncthreads();
      { const int tid = tidx(p), rw_ = grow0 + (tid & 255);
#pragma unroll 1
        for (int hh = 0; hh < 2; ++hh) qr_row(p, QRp + ((size_t)((pn - 4) * 4 + (tid >> 8) * 2 + hh) * SEQ + rw_) * 64, NMETA + rw_); }
    }
  }
}

DEVINL void phase_gemm3(const Params& p, char* lds) {
  const bf16_t* YM = (const bf16_t*)(wsp(p) + OFF_YM); const bf16_t* YN = (const bf16_t*)(wsp(p) + OFF_KN);
  const bf16_t* WoutT = (const bf16_t*)(wsp(p) + OFF_WOUT);
  for (int t = blockIdx.x; t < (SEQ / 256) * 4; t += gridDim.x) {
    const int pm = t % (SEQ / 256), pn = t / (SEQ / 256), brow = pm * 256;
    const float* xr = p.x + (size_t)brow * DM + pn * 256; float* od = p.out + (size_t)brow * DM + pn * 256;
    gemm_tile<true>(p, YM + (size_t)brow * 1024, YN + (size_t)brow * 1024, 16, 1024, WoutT + (size_t)pn * 256 * 2048, 2048, 2048 / BK, lds,
                    [=](int row, int col, f32x4 v) {
      const f32x4 xv = *reinterpret_cast<const f32x4*>(xr + (size_t)row * DM + col);
      f32x4 o = {xv[0] + v[0], xv[1] + v[1], xv[2] + v[2], xv[3] + v[3]};
      *reinterpret_cast<f32x4*>(od + (size_t)row * DM + col) = o;
    });
  }
}

constexpr float MLA_SCALE = 0.07216878364870322f;
constexpr float THR = 2.5f;
constexpr float PSHIFT = 5.f;
constexpr int KVBLK = 64;
constexpr int NT_MLA = 258;
constexpr int SHM_K8 = 9216, SHM_V8 = 8192;
constexpr int LDS_K = 0, LDS_V = 4 * SHM_K8, LDS_AW = LDS_V + 4 * SHM_V8;
using i32x8 = __attribute__((ext_vector_type(8))) int;
#define MFMA8(A, B, C) __builtin_amdgcn_mfma_scale_f32_32x32x64_f8f6f4(A, B, C, 0, 0, 0, 0x7f7f7f7f, 0, 0x7f7f7f7f)
DEVINL i32x8 mk6(int a, int b, int c, int d, int e, int f) { i32x8 r = __builtin_nondeterministic_value(r); r[0] = a; r[1] = b; r[2] = c; r[3] = d; r[4] = e; r[5] = f; return r; }
#define MFMA6(A, B, C) __builtin_amdgcn_mfma_scale_f32_32x32x64_f8f6f4(A, B, C, 2, 2, 0, 0x7f7f7f7f, 0, 0x7f7f7f7f)

DEVINL void partialSM(f32x16& p0, f32x16& p1, float& m_reg, float& mn, float& alpha, int kvalid, int hi) {
  constexpr float C = MLA_SCALE * 1.4426950408889634f;
  if (kvalid < 64) {
#pragma unroll
    for (int r = 0; r < 16; ++r) { if (crow(r, hi) >= kvalid) p0[r] = -1e30f; if (32 + crow(r, hi) >= kvalid) p1[r] = -1e30f; }
  }
  float pmax = p0[0];
#pragma unroll
  for (int r = 1; r < 16; ++r) pmax = fmaxf(pmax, p0[r]);
#pragma unroll
  for (int r = 0; r < 16; ++r) pmax = fmaxf(pmax, p1[r]);
  { auto rr = __builtin_amdgcn_permlane32_swap(__float_as_uint(pmax), __float_as_uint(pmax), false, false);
    pmax = fmaxf(__uint_as_float(rr[0]), __uint_as_float(rr[1])); }
  if (__builtin_expect(__all(pmax - m_reg <= THR / MLA_SCALE), 1)) { mn = m_reg; alpha = 1.f; }
  else { mn = fmaxf(m_reg, pmax); alpha = __builtin_amdgcn_exp2f((m_reg - mn) * C); m_reg = mn; }
  const float mnC = PSHIFT - mn * C;
  const f32x2 C2 = {C, C}, M2 = {mnC, mnC};
#pragma unroll
  for (int r = 0; r < 16; r += 2) { f32x2 v = {p0[r], p0[r + 1]}; v = __builtin_elementwise_fma(v, C2, M2); p0[r] = v[0]; p0[r + 1] = v[1]; }
#pragma unroll
  for (int r = 0; r < 16; r += 2) { f32x2 v = {p1[r], p1[r + 1]}; v = __builtin_elementwise_fma(v, C2, M2); p1[r] = v[0]; p1[r + 1] = v[1]; }
#pragma unroll
  for (int r = 0; r < 16; ++r) p0[r] = __builtin_amdgcn_exp2f(p0[r]);
}
#define PK4(P, BASE, OUT) do { unsigned a0 = cvtpk_v(P[BASE + 0], P[BASE + 1]), a1 = cvtpk_v(P[BASE + 2], P[BASE + 3]);   \
    unsigned b0 = cvtpk_v(P[BASE + 4], P[BASE + 5]), b1 = cvtpk_v(P[BASE + 6], P[BASE + 7]);                              \
    auto r0 = __builtin_amdgcn_permlane32_swap(a0, b0, false, false); auto r1 = __builtin_amdgcn_permlane32_swap(a1, b1, false, false); \
    u32x4 w = {r0[0], r1[0], r0[1], r1[1]}; OUT = *reinterpret_cast<bf16x8*>(&w); } while (0)
template <bool EXPDONE>
DEVINL void finishSM(f32x16& p0, f32x16& p1, float alpha, float& l_reg, i32x8& pa) {
  if (!EXPDONE) {
#pragma unroll
    for (int r = 0; r < 16; ++r) p1[r] = __builtin_amdgcn_exp2f(p1[r]);
  }
#pragma unroll
  for (int i = 0; i < 4; ++i) { pa[i] = pk8(p0[4 * i], p0[4 * i + 1], p0[4 * i + 2], p0[4 * i + 3]); pa[4 + i] = pk8(p1[4 * i], p1[4 * i + 1], p1[4 * i + 2], p1[4 * i + 3]); }
}
template <bool FUSE>
DEVINL void qkt(f32x16& p0, f32x16& p1, const char* Ks, const i32x8* q8, int r32, int hi, f32x16& e1) {
  p0 = f32x16{}; p1 = f32x16{};
  const char* ka = Ks + hi * 1024 + r32 * 16; const char* kb = Ks + 4096 + hi * 512 + r32 * 8;
  const char* ra = Ks + 6144 + hi * 1024 + r32 * 16; const char* rb = Ks + 6144 + 2048 + hi * 512 + r32 * 8;
  u32x4 fa[3][2]; u32x2 fb[3][2];
#define QK_LD(t, slot) do { if ((t) < 2) { \
      fa[slot][0] = *reinterpret_cast<const u32x4*>(ka + (t) * 2048); fa[slot][1] = *reinterpret_cast<const u32x4*>(ka + (t) * 2048 + 512); \
      fb[slot][0] = *reinterpret_cast<const u32x2*>(kb + (t) * 1024); fb[slot][1] = *reinterpret_cast<const u32x2*>(kb + (t) * 1024 + 256); } \
    else { \
      fa[slot][0] = *reinterpret_cast<const u32x4*>(ra); fa[slot][1] = *reinterpret_cast<const u32x4*>(ra + 512); \
      fb[slot][0] = *reinterpret_cast<const u32x2*>(rb); fb[slot][1] = *reinterpret_cast<const u32x2*>(rb + 256); } } while (0)
  QK_LD(0, 0);
#pragma unroll
  for (int t = 0; t < 3; ++t) {
    if (t + 1 < 3) QK_LD(t + 1, (t + 1) % 3);
    const i32x8 a0 = mk6((int)fa[t][0][0], (int)fa[t][0][1], (int)fa[t][0][2], (int)fa[t][0][3], (int)fb[t][0][0], (int)fb[t][0][1]);
    const i32x8 a1 = mk6((int)fa[t][1][0], (int)fa[t][1][1], (int)fa[t][1][2], (int)fa[t][1][3], (int)fb[t][1][0], (int)fb[t][1][1]);
    p0 = MFMA6(a0, q8[t], p0);
    if (FUSE) {
#pragma unroll
      for (int r = 0; r < 3; ++r) { const int rr = t * 6 + r; if (rr < 16) e1[rr] = __builtin_amdgcn_exp2f(e1[rr]); }
    }
    p1 = MFMA6(a1, q8[t], p1);
    if (FUSE) {
#pragma unroll
      for (int r = 3; r < 6; ++r) { const int rr = t * 6 + r; if (rr < 16) e1[rr] = __builtin_amdgcn_exp2f(e1[rr]); }
    }
    SBAR();
  }
#undef QK_LD
}
struct VFrag { u32x4 v[4][2]; };
DEVINL void pv_load(VFrag& f, const char* Vs, int r32, int hi) {
  const char* vb = Vs + hi * 1024 + r32 * 16;
#pragma unroll
  for (int db = 0; db < 4; ++db) { f.v[db][0] = *reinterpret_cast<const u32x4*>(vb + db * 2048); f.v[db][1] = *reinterpret_cast<const u32x4*>(vb + db * 2048 + 512); }
}
DEVINL void pv_mma(f32x16* o, const VFrag& f, const i32x8& pa) {
#pragma unroll
  for (int db = 0; db < 4; ++db) {
    const i32x8 b = {(int)f.v[db][0][0], (int)f.v[db][0][1], (int)f.v[db][0][2], (int)f.v[db][0][3], (int)f.v[db][1][0], (int)f.v[db][1][1], (int)f.v[db][1][2], (int)f.v[db][1][3]};
    o[db] = MFMA8(pa, b, o[db]);
  }
}

DEVINL void pv_psm(f32x16* o, const VFrag& f, const i32x8& pa, f32x16& lsum, const i32x8& ones8,
                   f32x16& p0, f32x16& p1, float& m_reg, float& mn, float& alpha, int kvalid, int hi) {
  constexpr float C = MLA_SCALE * 1.4426950408889634f;
#define PVM(db) do { const i32x8 b = {(int)f.v[db][0][0], (int)f.v[db][0][1], (int)f.v[db][0][2], (int)f.v[db][0][3], (int)f.v[db][1][0], (int)f.v[db][1][1], (int)f.v[db][1][2], (int)f.v[db][1][3]}; \
    o[db] = MFMA8(pa, b, o[db]); } while (0)
  if (kvalid < 64) {
#pragma unroll
    for (int r = 0; r < 16; ++r) { if (crow(r, hi) >= kvalid) p0[r] = -1e30f; if (32 + crow(r, hi) >= kvalid) p1[r] = -1e30f; }
  }
  PVM(0);
  float pmax = p0[0];
#pragma unroll
  for (int r = 1; r < 16; ++r) pmax = fmaxf(pmax, p0[r]);
  SBAR();
  PVM(1);
#pragma unroll
  for (int r = 0; r < 16; ++r) pmax = fmaxf(pmax, p1[r]);
  { auto rr = __builtin_amdgcn_permlane32_swap(__float_as_uint(pmax), __float_as_uint(pmax), false, false);
    pmax = fmaxf(__uint_as_float(rr[0]), __uint_as_float(rr[1])); }
  SBAR();
  PVM(2);
  if (__builtin_expect(__all(pmax - m_reg <= THR / MLA_SCALE), 1)) { mn = m_reg; alpha = 1.f; }
  else { mn = fmaxf(m_reg, pmax); alpha = __builtin_amdgcn_exp2f((m_reg - mn) * C); m_reg = mn; }
  const float mnC = PSHIFT - mn * C;
  const f32x2 C2 = {C, C}, M2 = {mnC, mnC};
#pragma unroll
  for (int r = 0; r < 16; r += 2) { f32x2 v = {p0[r], p0[r + 1]}; v = __builtin_elementwise_fma(v, C2, M2); p0[r] = v[0]; p0[r + 1] = v[1]; }
  SBAR();
  PVM(3);
#pragma unroll
  for (int r = 0; r < 16; r += 2) { f32x2 v = {p1[r], p1[r + 1]}; v = __builtin_elementwise_fma(v, C2, M2); p1[r] = v[0]; p1[r + 1] = v[1]; }
#pragma unroll
  for (int r = 0; r < 8; ++r) p0[r] = __builtin_amdgcn_exp2f(p0[r]);
  SBAR();
  lsum = MFMA8(ones8, pa, (f32x16{}));
#pragma unroll
  for (int r = 8; r < 16; ++r) p0[r] = __builtin_amdgcn_exp2f(p0[r]);
  SBAR();
#undef PVM
}

DEVINL void mla_block(const Params& p, const bf16_t* __restrict__ Qn, const bf16_t* __restrict__ Qr, const char* __restrict__ K8, const char* __restrict__ Kp8,
                      const char* __restrict__ V8, const bf16_t* __restrict__ Gb, bf16_t* __restrict__ Yb, char* lds, int pos0) {
  const int tid = tidx(p), wid = tid >> 6, lane = tid & 63, r32 = lane & 31, hi = lane >> 5;
  char* V_lds = lds + LDS_V; char* K_lds = lds + LDS_K;
  float* ws = (float*)(lds + LDS_AW) + wid * 64; float* li_l = ws; float* al_l = ws + 32;
  float m_reg = -1e30f, l_reg = 0; f32x16 o[4]; i32x8 q8[3];
  __syncthreads();
  {
    const int row = wid * 32 + r32;
    const char* qn = (const char*)(Qn + (size_t)row * 128); const char* qr = (const char*)(Qr + (size_t)row * 64);
#pragma unroll
    for (int t = 0; t < 3; ++t) {
      const u32x2* s = reinterpret_cast<const u32x2*>(t < 2 ? qn + (t * 2 + hi) * 24 : qr + hi * 24);
      const u32x2 w0 = s[0], w1 = s[1], w2 = s[2];
      q8[t] = mk6((int)w0[0], (int)w0[1], (int)w1[0], (int)w1[1], (int)w2[0], (int)w2[1]);
    }
  }
  SBAR();
#pragma unroll
  for (int d = 0; d < 4; ++d) o[d] = f32x16{};
  const int tid16 = tid * 16;
  const unsigned t16u = (unsigned)tid16;
#define GLDS(gp, lp) __builtin_amdgcn_global_load_lds((const unsigned*)(gp), (__attribute__((address_space(3))) unsigned*)(lp), 16, 0, 0)
#define ISSUE_K(j) do { const int _t = (j) < NT ? (j) : NT - 1; char* _d = K_lds + ((j) & 3) * SHM_K8; if (wid < 6) GLDS(K8 + (size_t)_t * 6144 + t16u, _d + tid16); \
    if (wid < 3) GLDS(Kp8 + (size_t)_t * 3072 + t16u, _d + 6144 + tid16); } while (0)
#define ISSUE_V(j) do { const int _t = (j) < NT ? (j) : NT - 1; GLDS(V8 + (size_t)_t * 8192 + t16u, V_lds + ((j) & 3) * SHM_V8 + tid16); } while (0)
#define KS(j) (K_lds + ((j) & 3) * SHM_K8)
#define VS(j) (V_lds + ((j) & 3) * SHM_V8)
#define TILE_SYNC() do { asm volatile("s_waitcnt vmcnt(0)" ::: "memory"); __syncthreads(); } while (0)
#define RESC(a) do { if (__any((a) < 1.f)) { if (hi == 0) al_l[r32] = (a); asm volatile("s_waitcnt lgkmcnt(0)" ::: "memory"); \
    for (int d = 0; d < 4; ++d) for (int r = 0; r < 16; ++r) o[d][r] *= al_l[crow(r, hi)]; } } while (0)
  f32x16 pA0, pA1, pB0, pB1; float mnA, mnB, alA, alB; i32x8 pa; VFrag vf; constexpr int NT = NT_MLA;
  const i32x8 ones8 = {0x38383838, 0x38383838, 0x38383838, 0x38383838, 0x38383838, 0x38383838, 0x38383838, 0x38383838};
  f32x16 lsum;
#define LSUM() do { lsum = MFMA8(ones8, pa, (f32x16{})); } while (0)
#define LUPD(al) do { l_reg = l_reg * (al) + lsum[0]; } while (0)
  ISSUE_K(0); ISSUE_K(1); ISSUE_K(2); ISSUE_V(0); ISSUE_V(1); TILE_SYNC();
  qkt<false>(pA0, pA1, KS(0), q8, r32, hi, pA1); partialSM(pA0, pA1, m_reg, mnA, alA, 64, hi);
  for (int j = 1; j + 1 < NT; j += 2) {
    ISSUE_K(j + 2); ISSUE_K(j + 3); ISSUE_V(j + 1); ISSUE_V(j + 2); SBAR();
    qkt<true>(pB0, pB1, KS(j), q8, r32, hi, pA1);
    pv_load(vf, VS(j - 1), r32, hi); SBAR();
    finishSM<true>(pA0, pA1, alA, l_reg, pa); SBAR();
    pv_psm(o, vf, pa, lsum, ones8, pB0, pB1, m_reg, mnB, alB, 64, hi);
    LUPD(alA); RESC(alB); SBAR();
    qkt<true>(pA0, pA1, KS(j + 1), q8, r32, hi, pB1);
    pv_load(vf, VS(j), r32, hi); SBAR();
    finishSM<true>(pB0, pB1, alB, l_reg, pa); SBAR();
    { const float alPrev = alB; pv_psm(o, vf, pa, lsum, ones8, pA0, pA1, m_reg, mnA, alA, L - (j + 1) * KVBLK, hi); LUPD(alPrev); }
    TILE_SYNC(); RESC(alA);
  }
  SBAR();
  qkt<true>(pB0, pB1, KS(NT - 1), q8, r32, hi, pA1);
  pv_load(vf, VS(NT - 2), r32, hi); SBAR();
  finishSM<true>(pA0, pA1, alA, l_reg, pa); SBAR();
  pv_psm(o, vf, pa, lsum, ones8, pB0, pB1, m_reg, mnB, alB, L - (NT - 1) * KVBLK, hi);
  LUPD(alA); RESC(alB);
  pv_load(vf, VS(NT - 1), r32, hi); SBAR();
  finishSM<false>(pB0, pB1, alB, l_reg, pa); SBAR();
  pv_mma(o, vf, pa); LSUM(); LUPD(alB);
  if (hi == 0) li_l[r32] = l_reg; asm volatile("s_waitcnt lgkmcnt(0)" ::: "memory");
  float rli[16];
#pragma unroll
  for (int r = 0; r < 16; ++r) rli[r] = __builtin_amdgcn_rcpf(li_l[crow(r, hi)]);
  asm volatile("s_waitcnt vmcnt(0)" ::: "memory");
  __syncthreads();
  float* ost = (float*)(lds + wid * 16384);
  {
    float* ow = ost + (4 * hi) * 128 + r32;
#pragma unroll
    for (int r = 0; r < 16; ++r)
#pragma unroll
      for (int d0 = 0; d0 < 4; ++d0) ow[((r & 3) + 8 * (r >> 2)) * 128 + d0 * 32] = o[d0][r] * rli[r];
  }
  asm volatile("s_waitcnt lgkmcnt(0)" ::: "memory");
  for (int it = 0; it < 8; ++it) {
    const int c = it * 64 + lane, row = c >> 4, col = (c & 15) * 8;
    const f32x4 a = *reinterpret_cast<const f32x4*>(ost + row * 128 + col), bq = *reinterpret_cast<const f32x4*>(ost + row * 128 + col + 4);
    const size_t off = (size_t)(wid * 32 + row) * 1024 + col;
    const u32x4 g = *reinterpret_cast<const u32x4*>(Gb + off);
    u32x4 y = {cvtpk(a[0] * bflo(g[0]), a[1] * bfhi(g[0])), cvtpk(a[2] * bflo(g[1]), a[3] * bfhi(g[1])),
               cvtpk(bq[0] * bflo(g[2]), bq[1] * bfhi(g[2])), cvtpk(bq[2] * bflo(g[3]), bq[3] * bfhi(g[3]))};
    *reinterpret_cast<u32x4*>(Yb + off) = y;
  }
#undef LSUM
#undef LUPD
#undef GLDS
#undef ISSUE_K
#undef ISSUE_V
#undef KS
#undef VS
#undef TILE_SYNC
#undef RESC
}

constexpr float LOG2E = 1.4426950408889634f;
constexpr float NA_THR = 12.f;
template <int QH>
DEVINL void na_half(const char* kbase, const char* vbase, char* qbase, const char* gbase, char* ybase, const char* tab  ,
                    const float* metab_h, const float* __restrict__ qw, int r0, int r32, int hi, unsigned loff) {
  const int qc = QH * 32 + r32;
  const unsigned qoff = (unsigned)qc * 2048u + (unsigned)hi * 16u;
  bf16x8 qf[4];
  {
    u32x4 raw[4];
#pragma unroll
    for (int d0 = 0; d0 < 4; ++d0) raw[d0] = *reinterpret_cast<const u32x4*>(qbase + qoff + d0 * 32);
    float ss = 0.f;
#pragma unroll
    for (int d0 = 0; d0 < 4; ++d0)
#pragma unroll
      for (int j = 0; j < 4; ++j) { const float a = bflo(raw[d0][j]), b = bfhi(raw[d0][j]); ss += a * a + b * b; }
    { auto rr = __builtin_amdgcn_permlane32_swap(__float_as_uint(ss), __float_as_uint(ss), false, false);
      ss = __uint_as_float(rr[0]) + __uint_as_float(rr[1]); }
    const float rq = rsqrtf(ss * (1.f / 64.f) + EPS) * 0.125f;
#pragma unroll
    for (int d0 = 0; d0 < 4; ++d0) {
      const f32x4 w0 = *reinterpret_cast<const f32x4*>(qw + d0 * 16 + hi * 8), w1 = *reinterpret_cast<const f32x4*>(qw + d0 * 16 + hi * 8 + 4);
      u32x4 o = {cvtpk(bflo(raw[d0][0]) * rq * w0[0], bfhi(raw[d0][0]) * rq * w0[1]), cvtpk(bflo(raw[d0][1]) * rq * w0[2], bfhi(raw[d0][1]) * rq * w0[3]),
                 cvtpk(bflo(raw[d0][2]) * rq * w1[0], bfhi(raw[d0][2]) * rq * w1[1]), cvtpk(bflo(raw[d0][3]) * rq * w1[2], bfhi(raw[d0][3]) * rq * w1[3])};
      qf[d0] = *reinterpret_cast<bf16x8*>(&o);
    }
  }
  const int c0 = min(max(qc - 8, 0), 48);
  int ad[20];
#pragma unroll
  for (int i = 0; i < 20; ++i) {
    const int kc = i < 16 ? QH * 32 + crow(i, hi) : (QH == 0 ? 32 + crow(i - 16, hi) : crow(12 + (i - 16), hi));
    ad[i] = ((kc >= c0 && kc < c0 + 16) ? kc - qc + 15 : 31) * 4;
  }
  float m = -1e30f, l = 0.f; f32x16 o0 = {}, o1 = {};
  bf16x8 kf[8], vf[6];
  { const char* kp = kbase + (size_t)(1 + r0 * 2) * 4 * 1024;
#pragma unroll
    for (int i = 0; i < 8; ++i) kf[i] = *reinterpret_cast<const bf16x8*>(kp + loff + i * 1024); }
#pragma unroll 1
  for (int step = 0; step < 8; ++step) {
    f32x16 s0 = {}, s1 = {};
#pragma unroll
    for (int d0 = 0; d0 < 4; ++d0) {
      s0 = __builtin_amdgcn_mfma_f32_32x32x16_bf16(kf[d0], qf[d0], s0, 0, 0, 0);
      s1 = __builtin_amdgcn_mfma_f32_32x32x16_bf16(kf[4 + d0], qf[d0], s1, 0, 0, 0);
    }
    SBAR();
    { const char* kp = kbase + (step < 7 ? (size_t)(1 + (r0 + step + 1) * 2) * 4 * 1024 : (size_t)0);
#pragma unroll
      for (int i = 0; i < 8; ++i) kf[i] = *reinterpret_cast<const bf16x8*>(kp + loff + i * 1024); }
    { const char* vp = vbase + (size_t)(1 + (r0 + step) * 4 + QH) * 2 * 1024;
#pragma unroll
      for (int i = 0; i < 6; ++i) vf[i] = *reinterpret_cast<const bf16x8*>(vp + loff + i * 1024); }
    SBAR();
    const char* tb = tab + step * 128;
    float e[20];
    float pmax = -1e30f;
#pragma unroll
    for (int i = 0; i < 20; ++i) {
      const float sv = i < 16 ? (QH == 0 ? s0[i] : s1[i]) : (QH == 0 ? s1[i - 16] : s0[12 + (i - 16)]);
      e[i] = fmaf(sv, LOG2E, *reinterpret_cast<const float*>(tb + ad[i]));
      pmax = fmaxf(pmax, e[i]);
    }
    { auto rr = __builtin_amdgcn_permlane32_swap(__float_as_uint(pmax), __float_as_uint(pmax), false, false);
      pmax = fmaxf(__uint_as_float(rr[0]), __uint_as_float(rr[1])); }
    if (!__all(pmax - m <= NA_THR)) {
      const float mn = fmaxf(m, pmax), alpha = __builtin_amdgcn_exp2f(m - mn); m = mn;
      l *= alpha;
#pragma unroll
      for (int reg = 0; reg < 16; ++reg) { o0[reg] *= alpha; o1[reg] *= alpha; }
    }
    float ps = 0.f;
#pragma unroll
    for (int i = 0; i < 20; ++i) { e[i] = __builtin_amdgcn_exp2f(e[i] - m); ps += e[i]; }
    { auto rr = __builtin_amdgcn_permlane32_swap(__float_as_uint(ps), __float_as_uint(ps), false, false);
      ps = __uint_as_float(rr[0]) + __uint_as_float(rr[1]); }
    l += ps;
    float pd[16], px[8];
#pragma unroll
    for (int i = 0; i < 16; ++i) pd[i] = e[i];
#pragma unroll
    for (int i = 0; i < 8; ++i) px[i] = QH == 0 ? (i < 4 ? e[16 + i] : 0.f) : (i >= 4 ? e[16 + (i - 4)] : 0.f);
    bf16x8 pa0, pa1, pa2;
    if (QH == 0) { PK4(pd, 0, pa0); PK4(pd, 8, pa1); PK4(px, 0, pa2); }
    else         { PK4(px, 0, pa0); PK4(pd, 0, pa1); PK4(pd, 8, pa2); }
    o0 = __builtin_amdgcn_mfma_f32_32x32x16_bf16(vf[0], pa0, o0, 0, 0, 0); o1 = __builtin_amdgcn_mfma_f32_32x32x16_bf16(vf[1], pa0, o1, 0, 0, 0);
    o0 = __builtin_amdgcn_mfma_f32_32x32x16_bf16(vf[2], pa1, o0, 0, 0, 0); o1 = __builtin_amdgcn_mfma_f32_32x32x16_bf16(vf[3], pa1, o1, 0, 0, 0);
    o0 = __builtin_amdgcn_mfma_f32_32x32x16_bf16(vf[4], pa2, o0, 0, 0, 0); o1 = __builtin_amdgcn_mfma_f32_32x32x16_bf16(vf[5], pa2, o1, 0, 0, 0);
  }
  {
    vf[0] = *reinterpret_cast<const bf16x8*>(vbase + loff); vf[1] = *reinterpret_cast<const bf16x8*>(vbase + loff + 1024);
    f32x16 s0 = {};
#pragma unroll
    for (int d0 = 0; d0 < 4; ++d0) s0 = __builtin_amdgcn_mfma_f32_32x32x16_bf16(kf[d0], qf[d0], s0, 0, 0, 0);
    float e[8];
    float pmax = -1e30f;
#pragma unroll
    for (int i = 0; i < 8; ++i) { e[i] = fmaf(s0[i], LOG2E, metab_h[crow(i, hi)]); pmax = fmaxf(pmax, e[i]); }
    { auto rr = __builtin_amdgcn_permlane32_swap(__float_as_uint(pmax), __float_as_uint(pmax), false, false);
      pmax = fmaxf(__uint_as_float(rr[0]), __uint_as_float(rr[1])); }
    if (!__all(pmax - m <= NA_THR)) {
      const float mn = fmaxf(m, pmax), alpha = __builtin_amdgcn_exp2f(m - mn); m = mn;
      l *= alpha;
#pragma unroll
      for (int reg = 0; reg < 16; ++reg) { o0[reg] *= alpha; o1[reg] *= alpha; }
    }
    float ps = 0.f;
#pragma unroll
    for (int i = 0; i < 8; ++i) { e[i] = __builtin_amdgcn_exp2f(e[i] - m); ps += e[i]; }
    { auto rr = __builtin_amdgcn_permlane32_swap(__float_as_uint(ps), __float_as_uint(ps), false, false);
      ps = __uint_as_float(rr[0]) + __uint_as_float(rr[1]); }
    l += ps;
    bf16x8 pa0;
    PK4(e, 0, pa0);
    o0 = __builtin_amdgcn_mfma_f32_32x32x16_bf16(vf[0], pa0, o0, 0, 0, 0);
    o1 = __builtin_amdgcn_mfma_f32_32x32x16_bf16(vf[1], pa0, o1, 0, 0, 0);
  }
  const float rl = __builtin_amdgcn_rcpf(l);
  const unsigned eoff = (unsigned)qc * 2048u + (unsigned)hi * 8u;
#pragma unroll
  for (int q4 = 0; q4 < 4; ++q4) {
    const u32x2 g0 = *reinterpret_cast<const u32x2*>(gbase + eoff + q4 * 16), g1 = *reinterpret_cast<const u32x2*>(gbase + eoff + 64 + q4 * 16);
    u32x2 w0 = {cvtpk(o0[4 * q4 + 0] * rl * bflo(g0[0]), o0[4 * q4 + 1] * rl * bfhi(g0[0])), cvtpk(o0[4 * q4 + 2] * rl * bflo(g0[1]), o0[4 * q4 + 3] * rl * bfhi(g0[1]))};
    u32x2 w1 = {cvtpk(o1[4 * q4 + 0] * rl * bflo(g1[0]), o1[4 * q4 + 1] * rl * bfhi(g1[0])), cvtpk(o1[4 * q4 + 2] * rl * bflo(g1[1]), o1[4 * q4 + 3] * rl * bfhi(g1[1]))};
    *reinterpret_cast<u32x2*>(ybase + eoff + q4 * 16) = w0; *reinterpret_cast<u32x2*>(ybase + eoff + 64 + q4 * 16) = w1;
  }
}
DEVINL void na_item(const Params& p, int r, int h, int qh, const float* relb_l, const float* metab_l) {
  const int lane = tidx(p) & 63, r32 = lane & 31, hi = lane >> 5;
  const int r0 = min(max(r - 4, 0), 256 - 8);
  const char* kbase = (const char*)(wsp(p) + OFF_NAK) + (size_t)h * 513 * 4 * 1024;
  const char* vbase = (const char*)(wsp(p) + OFF_VT) + (size_t)h * 1025 * 2 * 1024;
  char* qbase = (char*)(wsp(p) + OFF_NAQ) + ((size_t)(NMETA + r * 64) * 1024 + h * 64) * 2;
  const char* gbase = (const char*)p.out + ((size_t)SEQ * 1024 + (size_t)r * 64 * 1024 + h * 64) * 2;
  char* ybase = (char*)(wsp(p) + OFF_KN) + ((size_t)r * 64 * 1024 + h * 64) * 2;
  const unsigned loff = lane * 16;
  const char* tab = (const char*)relb_l + ((h * 15 + (r0 - r + 7)) * 32) * 4;
  if (qh == 0) na_half<0>(kbase, vbase, qbase, gbase, ybase, tab, metab_l + h * 16, p.naq_w, r0, r32, hi, loff);
  else         na_half<1>(kbase, vbase, qbase, gbase, ybase, tab, metab_l + h * 16, p.naq_w, r0, r32, hi, loff);
}

DEVINL void phase_attn(const Params& p, char* lds) {
#ifndef NO_MLA
  {
    const bf16_t* QN = (const bf16_t*)(wsp(p) + OFF_QN); const bf16_t* QRp = (const bf16_t*)(wsp(p) + OFF_QR);
    const char* K8 = (const char*)(wsp(p) + OFF_K8); const char* KP8 = (const char*)(wsp(p) + OFF_KP8); const char* V8 = (const char*)(wsp(p) + OFF_V);
    const bf16_t* G = (const bf16_t*)p.out; bf16_t* YM = (bf16_t*)(wsp(p) + OFF_YM);
    for (int it = blockIdx.x; it < 512; it += gridDim.x) {
      const int h = it & 7, qb = it >> 3;
      mla_block(p, QN + ((size_t)h * SEQ + qb * 256) * 128, QRp + ((size_t)h * SEQ + qb * 256) * 64, K8 + (size_t)h * (LP / 64) * 6144, KP8, V8 + (size_t)h * (LP / 64) * 8192,
                G + (size_t)qb * 256 * 1024 + h * 128, YM + (size_t)qb * 256 * 1024 + h * 128, lds, NMETA + qb * 256);
    }
  }
#endif
#ifndef NO_NA
  __syncthreads();
  float* relb_l = (float*)lds; float* metab_l = relb_l + 16 * 15 * 32;
  for (int i = tidx(p); i < 16 * 15 * 32; i += NTHREADS) { const int dc = i & 31, hd = i >> 5; relb_l[i] = dc < 31 ? p.relb[hd * 31 + dc] * LOG2E : -1e30f; }
  for (int i = tidx(p); i < 256; i += NTHREADS) metab_l[i] = p.metab[i] * LOG2E;
  __syncthreads();
  const int wave = __builtin_amdgcn_readfirstlane(tidx(p) >> 6);
  const int xcdn = blockIdx.x & 7, bixn = blockIdx.x >> 3, nbxn = gridDim.x >> 3;
  for (int i = bixn; i < 128; i += nbxn) {
    const int g = i & 63, h = xcdn * 2 + (i >> 6);
    na_item(p, g * 4 + (wave >> 1), h, wave & 1, relb_l, metab_l);
  }
#endif
}

#define XB_TMO      128
#define XB_XCNT(j)  (256  + 64 * (j))
#define XB_XSUB(j)  (1280 + 64 * (j))
#define XB_XGEN(j)  (2304 + 64 * (j))
#define XB_TOP      3328
#define XB_TOPGEN   3392
#define XB_SPIN_CAP (1u << 22)
DEVINL unsigned xb_ld(unsigned* q)              { return __hip_atomic_load(q, __ATOMIC_RELAXED, __HIP_MEMORY_SCOPE_AGENT); }
DEVINL unsigned xb_add(unsigned* q, unsigned v) { return __hip_atomic_fetch_add(q, v, __ATOMIC_RELAXED, __HIP_MEMORY_SCOPE_AGENT); }
DEVINL unsigned xb_xcc_id() { return (unsigned)__builtin_amdgcn_s_getreg((3 << 11) | 20) & 0xFu; }
#define XB_SPIN(cond, bar) do { unsigned _sp = 0; while (cond) { __builtin_amdgcn_s_sleep(1); \
    if ((++_sp & 255u) == 0u) { if (xb_ld(&(bar)[XB_TMO])) break; if (_sp > XB_SPIN_CAP) { atomicAdd(&(bar)[XB_TMO], 1u); break; } } } } while (0)
DEVINL void xcd_barrier_post(const Params& p, unsigned* bar, volatile unsigned* st) {
  if (tidx(p) == 0) { st[0] = 0u; st[1] = 0u; (void)xb_add(&bar[XB_XCNT(xb_xcc_id())], 1u); }
  __syncthreads();
}
DEVINL void xcd_barrier_complete(unsigned* bar, unsigned x, unsigned& nloc, unsigned& nx) {
  const unsigned G = gridDim.x;
  unsigned sum, cnt, mine, sp = 0u;
  for (;;) {
    sum = 0u; cnt = 0u; mine = 0u;
#pragma unroll
    for (unsigned j = 0; j < 16; ++j) { const unsigned c = xb_ld(&bar[XB_XCNT(j)]); sum += c; cnt += (c > 0u) ? 1u : 0u; mine = (j == x) ? c : mine; }
    if (sum == G) break;
    __builtin_amdgcn_s_sleep(1);
    if ((++sp & 255u) == 0u) { if (xb_ld(&bar[XB_TMO])) break; if (sp > XB_SPIN_CAP) { atomicAdd(&bar[XB_TMO], 1u); break; } }
  }
  nloc = mine > 0u ? mine : 1u; nx = cnt > 0u ? cnt : 1u;
}
DEVINL void grid_barrier(const Params& p, unsigned* bar, volatile unsigned* st) {
  asm volatile("s_waitcnt vmcnt(0) lgkmcnt(0)" ::: "memory");
  __syncthreads();
  if (tidx(p) == 0) {
    const unsigned x = xb_xcc_id();
    __builtin_amdgcn_s_waitcnt(0);
    unsigned nloc = st[0], nx = st[1];
    if (nloc == 0u) { xcd_barrier_complete(bar, x, nloc, nx); st[0] = nloc; st[1] = nx; }
    const unsigned old = xb_add(&bar[XB_XSUB(x)], 1u);
    const unsigned gen = old / nloc;
    if (old + 1u == (gen + 1u) * nloc) {
      __builtin_amdgcn_fence(__ATOMIC_RELEASE, "agent");
      asm volatile("s_waitcnt vmcnt(0)" ::: "memory");
      const unsigned og = xb_add(&bar[XB_TOP], 1u);
      const unsigned tg = og / nx;
      if (og + 1u == (tg + 1u) * nx) xb_add(&bar[XB_TOPGEN], 1u);
      else XB_SPIN(xb_ld(&bar[XB_TOPGEN]) == tg, bar);
      __builtin_amdgcn_fence(__ATOMIC_ACQUIRE, "agent");
      xb_add(&bar[XB_XGEN(x)], 1u);
      asm volatile("s_waitcnt vmcnt(0)" ::: "memory");
    } else {
      XB_SPIN(xb_ld(&bar[XB_XGEN(x)]) == gen, bar);
      __builtin_amdgcn_fence(__ATOMIC_ACQUIRE, "agent");
      asm volatile("s_waitcnt vmcnt(0)" ::: "memory");
    }
  }
  __syncthreads();
}

__global__ void __launch_bounds__(NTHREADS) mega(Params p, int ph_lo, int ph_hi) {
  extern __shared__ __attribute__((aligned(16))) char shm[];
  if (ph_hi > 64) cg::this_grid().sync();
  p.tid0 = __builtin_amdgcn_readfirstlane((int)threadIdx.x);
  volatile unsigned* xst = (volatile unsigned*)(shm + LDS_XB);
  xcd_barrier_post(p, (unsigned*)(wsp(p) + OFF_BAR), xst);
#define SEAM(k) do { if (ph_lo < (k) && (k) < ph_hi) grid_barrier(p, (unsigned*)(wsp(p) + OFF_BAR), xst); } while (0)
#define RUNS(k) (ph_lo <= (k) && (k) < ph_hi)
#ifdef ONLY_PHASE
  if (ONLY_PHASE == 0) phase_prep(p, shm);
  if (ONLY_PHASE == 1) phase_gemm1(p, shm);
  if (ONLY_PHASE == 2) phase_gemm2(p, shm);
  if (ONLY_PHASE == 4) phase_attn(p, shm);
  if (ONLY_PHASE == 5) phase_gemm3(p, shm);
#else
  if (RUNS(0)) phase_prep(p, shm);
  SEAM(1);
  if (RUNS(1)) phase_gemm1(p, shm);
  SEAM(2);
  if (RUNS(2)) phase_gemm2(p, shm);
  SEAM(4);
  if (RUNS(4)) phase_attn(p, shm);
  SEAM(5);
  if (RUNS(5)) phase_gemm3(p, shm);
#endif
#undef SEAM
#undef RUNS
}

extern "C" void kernel_launch(void* const* d_in, const int* in_sizes, int n_in, void* d_out, int out_size, void* d_ws, size_t ws_size, hipStream_t stream) {
  static int grid = 0;
  if (grid == 0) {
    if (n_in != 17 || in_sizes[0] != SEQ * DM || out_size != SEQ * DM || ws_size < WS_END) {
      fprintf(stderr, "kernel_launch: shape mismatch n_in %d in0 %d out %d ws %zu (need %zu)\n", n_in, n_in > 0 ? in_sizes[0] : -1, out_size, ws_size, (size_t)WS_END);
      grid = -1; return; }
    int dev = 0, cus = 0, per_cu = 0;
    hipGetDevice(&dev);
    hipDeviceGetAttribute(&cus, hipDeviceAttributeMultiprocessorCount, dev);
    if (hipFuncSetAttribute((const void*)mega, hipFuncAttributeMaxDynamicSharedMemorySize, LDS_BYTES) != hipSuccess) { fprintf(stderr, "kernel_launch: hipFuncSetAttribute failed\n"); grid = -1; return; }
    if (hipOccupancyMaxActiveBlocksPerMultiprocessor(&per_cu, (const void*)mega, NTHREADS, LDS_BYTES) != hipSuccess || per_cu < 1) {
      fprintf(stderr, "kernel_launch: occupancy query gave %d\n", per_cu); (void)hipGetLastError(); per_cu = 1; }
    grid = cus * 1;
    if (grid <= 0) grid = 256;
  }
  if (grid < 0) return;
  Params p{};
  const float** f = (const float**)&p;
  for (int i = 0; i < 17; ++i) f[i] = (const float*)d_in[i];
  p.out = (float*)d_out; p.ws = (unsigned char*)d_ws;
#if N_LAUNCHES == 1
  if (hipMemsetAsync((char*)d_ws + OFF_BAR, 0, BAR_BYTES, stream) != hipSuccess) { fprintf(stderr, "kernel_launch: memset of the barrier words failed\n"); return; }
  int lo = 0, hi = 6;
  void* args[] = {&p, &lo, &hi};
  hipError_t e = hipLaunchCooperativeKernel((const void*)mega, dim3(grid), dim3(NTHREADS), args, LDS_BYTES, stream);
  if (e != hipSuccess) fprintf(stderr, "cooperative launch failed: %s (grid %d)\n", hipGetErrorString(e), grid);
#else
  for (int ph = 0; ph < 6; ++ph) {
    hipLaunchKernelGGL(mega, dim3(grid), dim3(NTHREADS), LDS_BYTES, stream, p, ph, ph + 1);
  }
  hipError_t e = hipPeekAtLastError();
  if (e != hipSuccess) fprintf(stderr, "launch failed: %s\n", hipGetErrorString(e));
#endif
}
```

```cpp
#include <hip/hip_runtime.h>
#include <hip/hip_bf16.h>
#include <hip/hip_cooperative_groups.h>
#include <cstdio>
#include <cstdint>
namespace cg = cooperative_groups;

#ifndef N_LAUNCHES
#define N_LAUNCHES 1
#endif

#define DEVINL __device__ __forceinline__
typedef unsigned short bf16_t;
using bf16x8 = __attribute__((ext_vector_type(8))) short;
using s16x4  = __attribute__((ext_vector_type(4))) short;
using f32x16 = __attribute__((ext_vector_type(16))) float;
using f32x4  = __attribute__((ext_vector_type(4))) float;
using u32x4  = __attribute__((ext_vector_type(4))) unsigned;
using u32x2  = __attribute__((ext_vector_type(2))) unsigned;
using f32x2  = __attribute__((ext_vector_type(2))) float;

constexpr int DM = 1024, SEQ = 16384, NMETA = 16, L = SEQ + NMETA, LP = 16640;
constexpr int NPROJ = 5696, NPROJ_P = 5888;
constexpr int NHM = 8, NOPE = 128, ROPE = 64, VD = 128, QR = 256, KVR = 256;
constexpr int NHN = 16, DHN = 64;
constexpr float EPS = 1e-6f;
constexpr int NTHREADS = 512;
constexpr int LDS_XB = 131072 + 1024;
constexpr int LDS_BYTES = LDS_XB + 256;

constexpr size_t OFF_WUQ  = 0;
constexpr size_t OFF_WUKV = OFF_WUQ + (size_t)1536 * 256 * 2;
constexpr size_t OFF_WOUT = OFF_WUKV + (size_t)2048 * 256 * 2;
constexpr size_t OFF_R1   = OFF_WOUT + (size_t)1024 * 2048 * 2;
constexpr size_t OFF_KPE  = OFF_R1 + (size_t)LP * 4;
constexpr size_t OFF_NAQ  = OFF_KPE + (size_t)LP * 64 * 2;
constexpr size_t OFF_NAK  = OFF_NAQ + (size_t)LP * 1024 * 2;
constexpr size_t OFF_VT   = OFF_NAK + (size_t)LP * 1024 * 2;
constexpr size_t OFF_KN   = OFF_VT + (size_t)LP * 1024 * 2;
constexpr size_t OFF_V    = OFF_KN + (size_t)8 * LP * 128 * 2;
constexpr size_t OFF_X    = OFF_V + (size_t)8 * LP * 128 * 2;
constexpr size_t OFF_QN   = OFF_X;
constexpr size_t OFF_QR   = OFF_QN + (size_t)8 * SEQ * 128 * 2;
constexpr size_t OFF_YM   = OFF_QR + (size_t)8 * SEQ * 64 * 2;
constexpr size_t OFF_KP8  = OFF_YM + (size_t)SEQ * 1024 * 2;
constexpr size_t OFF_BAR  = OFF_KP8 + (size_t)(LP / 64) * 4096;
constexpr size_t BAR_BYTES = 16384;
constexpr size_t WS_END   = OFF_BAR + BAR_BYTES;
constexpr size_t OFF_K8   = OFF_V + (size_t)8 * (LP / 64) * 8192;
constexpr size_t OFF_HB   = OFF_X;
constexpr size_t OFF_WIN  = OFF_HB + (size_t)LP * 1024 * 2;
constexpr size_t OFF_LAT  = OFF_YM;
static_assert(OFF_WIN + (size_t)NPROJ_P * 1024 * 2 <= OFF_YM, "Hb/WinT must not overlap LAT");
static_assert(OFF_LAT + (size_t)LP * 512 * 2 <= WS_END, "LAT fits");
static_assert(WS_END <= (size_t)256 * 1024 * 1024, "workspace fits 256 MiB");

struct Params {
  const float *x, *meta, *norm_w, *w_in, *qlw, *kvlw, *w_uq, *w_ukv, *qn_w, *qpe_w, *kn_w, *kpe_w, *naq_w, *nak_w, *relb, *metab, *w_out;
  float* out;
  unsigned char* ws;
  int tid0;
  int pad_;
};

DEVINL int tidx(const Params& p) { int l; asm volatile("v_mbcnt_lo_u32_b32 %0, -1, 0\n\tv_mbcnt_hi_u32_b32 %0, -1, %0" : "=v"(l)); return p.tid0 + l; }
DEVINL unsigned char* wsp(const Params& p) { unsigned char* w = p.ws; asm volatile("" : "+s"(w)); return w; }
DEVINL unsigned cvtpk(float lo, float hi) { unsigned r; asm("v_cvt_pk_bf16_f32 %0, %1, %2" : "=v"(r) : "v"(lo), "v"(hi)); return r; }
DEVINL unsigned cvtpk_v(float lo, float hi) { unsigned r; asm volatile("v_cvt_pk_bf16_f32 %0, %1, %2" : "=v"(r) : "v"(lo), "v"(hi)); return r; }
DEVINL int pk8(float a, float b, float c, float d) { int w = 0; w = __builtin_amdgcn_cvt_pk_fp8_f32(a, b, w, false); w = __builtin_amdgcn_cvt_pk_fp8_f32(c, d, w, true); return w; }
using i32x6 = __attribute__((ext_vector_type(6))) int;
DEVINL i32x6 pk6(const f32x16& a, const f32x16& b) { return __builtin_amdgcn_cvt_scalef32_2xpk16_fp6_f32(a, b, 1.0f); }
DEVINL float bf2f(unsigned short u) { return __uint_as_float(((unsigned)u) << 16); }
DEVINL float bflo(unsigned u) { return __uint_as_float(u << 16); }
DEVINL float bfhi(unsigned u) { return __uint_as_float(u & 0xffff0000u); }
DEVINL int crow(int r, int hi) { return (r & 3) + 8 * (r >> 2) + 4 * hi; }
DEVINL float silu(float v) { return v / (1.f + __expf(-v)); }
#define SBAR() __builtin_amdgcn_sched_barrier(0)
DEVINL int v_st(int k, int c) { const int kk = (k & ~0xC) | ((k & 4) << 1) | ((k & 8) >> 1); return ((kk >> 3) * 4 + (c >> 5)) * 512 + ((kk & 7) * 32 + (c & 31)) * 2; }

DEVINL void tr_tile(const Params& p, const float* __restrict__ src, int sld, int sc0, int k0, const float* __restrict__ scale, bf16_t* __restrict__ dst, int dld, int n0, float* tile) {
  const int tid = tidx(p);
  __syncthreads();
  {
    const int kk = tid >> 4, nn = (tid & 15) * 4;
#pragma unroll
    for (int i = 0; i < 2; ++i) {
      const int k = kk + i * 32;
      float4 v = make_float4(0.f, 0.f, 0.f, 0.f);
      if (sc0 >= 0) {
        v = *reinterpret_cast<const float4*>(src + (size_t)(k0 + k) * sld + sc0 + nn);
        const float s = scale ? scale[k0 + k] : 1.f;
        v.x *= s; v.y *= s; v.z *= s; v.w *= s;
      }
      tile[k * 65 + nn + 0] = v.x; tile[k * 65 + nn + 1] = v.y; tile[k * 65 + nn + 2] = v.z; tile[k * 65 + nn + 3] = v.w;
    }
  }
  __syncthreads();
  {
    const int n = tid >> 3, kc = (tid & 7) * 8;
    float f[8];
#pragma unroll
    for (int j = 0; j < 8; ++j) f[j] = tile[(kc + j) * 65 + n];
    u32x4 w = {cvtpk(f[0], f[1]), cvtpk(f[2], f[3]), cvtpk(f[4], f[5]), cvtpk(f[6], f[7])};
    *reinterpret_cast<u32x4*>(dst + (size_t)(n0 + n) * dld + k0 + kc) = w;
  }
}

DEVINL void phase_prep(const Params& p, char* lds) {
  const int tid = tidx(p), wave = tid >> 6, lane = tid & 63;
  bf16_t* Hb = (bf16_t*)(wsp(p) + OFF_HB);
  float* r1 = (float*)(wsp(p) + OFF_R1);
  for (int row = blockIdx.x * 8 + wave; row < LP; row += gridDim.x * 8) {
    bf16_t* dst = Hb + (size_t)row * DM;
    if (row < L) {
      const float* src = row < NMETA ? p.meta + (size_t)row * DM : p.x + (size_t)(row - NMETA) * DM;
      float ss = 0.f;
#pragma unroll
      for (int i = 0; i < 4; ++i) {
        float4 v = *reinterpret_cast<const float4*>(src + (lane + 64 * i) * 4);
        ss += v.x * v.x + v.y * v.y + v.z * v.z + v.w * v.w;
        u32x2 w = {cvtpk(v.x, v.y), cvtpk(v.z, v.w)};
        *reinterpret_cast<u32x2*>(dst + (lane + 64 * i) * 4) = w;
      }
#pragma unroll
      for (int o = 32; o >= 1; o >>= 1) ss += __shfl_xor(ss, o);
      if (lane == 0) r1[row] = rsqrtf(ss * (1.f / DM) + EPS);
    } else {
#pragma unroll
      for (int i = 0; i < 4; ++i) { u32x2 w = {0u, 0u}; *reinterpret_cast<u32x2*>(dst + (lane + 64 * i) * 4) = w; }
      if (lane == 0) r1[row] = 0.f;
    }
  }
  float* tile = (float*)lds;
  bf16_t* WinT = (bf16_t*)(wsp(p) + OFF_WIN); bf16_t* WuqT = (bf16_t*)(wsp(p) + OFF_WUQ);
  bf16_t* WukvT = (bf16_t*)(wsp(p) + OFF_WUKV); bf16_t* WoutT = (bf16_t*)(wsp(p) + OFF_WOUT);
  constexpr int J_IN = 92 * 16, J_UQ = 24 * 4, J_UKV = 32 * 4, J_OUT = 16 * 32;
  for (int j = blockIdx.x; j < J_IN + J_UQ + J_UKV + J_OUT; j += gridDim.x) {
    if (j < J_IN) {
      const int nb = j >> 4, kb = j & 15, n0 = nb * 64;
      int sc0;
      if (n0 < 512) sc0 = n0;
      else if (n0 < 1536) sc0 = n0 - 512 + 576;
      else if (n0 < 2560) sc0 = n0 - 1536 + 1600;
      else if (n0 < 3584) sc0 = n0 - 2560 + 2624;
      else if (n0 < 4608) sc0 = n0 - 3584 + 3648;
      else if (n0 < 5632) sc0 = n0 - 4608 + 4672;
      else if (n0 < 5696) sc0 = 512;
      else sc0 = -1;
      tr_tile(p, p.w_in, NPROJ, sc0, kb * 64, p.norm_w, WinT, DM, n0, tile);
    } else if (j < J_IN + J_UQ) {
      const int jj = j - J_IN, nb = jj >> 2, kb = jj & 3;
      const int sc0 = nb < 16 ? (nb >> 1) * 192 + (nb & 1) * 64 : (nb - 16) * 192 + 128;
      tr_tile(p, p.w_uq, 1536, sc0, kb * 64, p.qlw, WuqT, QR, nb * 64, tile);
    } else if (j < J_IN + J_UQ + J_UKV) {
      const int jj = j - J_IN - J_UQ, nb = jj >> 2, kb = jj & 3;
      const int sc0 = nb < 16 ? (nb >> 1) * 256 + (nb & 1) * 64 : ((nb - 16) >> 1) * 256 + 128 + ((nb - 16) & 1) * 64;
      tr_tile(p, p.w_ukv, 2048, sc0, kb * 64, p.kvlw, WukvT, KVR, nb * 64, tile);
    } else {
      const int jj = j - J_IN - J_UQ - J_UKV, nb = jj >> 5, kb = jj & 31;
      tr_tile(p, p.w_out, DM, nb * 64, kb * 64, nullptr, WoutT, 2048, nb * 64, tile);
    }
  }
}

constexpr int BK = 64, HALF = 128, HT = HALF * BK;
DEVINL int lds_byte(int r, int c) {
  int st = (r >> 4) * 2 + (c >> 5), rr = r & 15, cc = c & 31, ob = rr * 64 + cc * 2;
  return st * 1024 + (ob ^ (((ob >> 9) & 1) << 5));
}
DEVINL void stage_rc(int b, int& R, int& C) {
  int st = b / 1024, sb = b % 1024, swz = sb ^ (((sb >> 9) & 1) << 5);
  R = (st >> 1) * 16 + swz / 64; C = (st & 1) * 32 + (swz % 64) / 2;
}

template <bool SWAP, class Epi>
DEVINL void gemm_tile(const Params& p, const bf16_t* __restrict__ A0, const bf16_t* __restrict__ A1, int ksplit, int lda,
                      const bf16_t* __restrict__ Bt, int ldb, int nt, char* shmc, Epi epi) {
  bf16_t* shm = (bf16_t*)shmc;
#define SA(b, h) (shm + ((b) * 2 + (h)) * HT)
#define SB(b, h) (shm + (4 + (b) * 2 + (h)) * HT)
#define APTR(kt) (((kt) < ksplit ? A0 + (size_t)(kt) * BK : A1 + (size_t)((kt) - ksplit) * BK))
#define STAGE_A(P, hh, kt) do { const bf16_t* _base = APTR(kt) + (size_t)(hh) * HALF * lda; \
    __builtin_amdgcn_global_load_lds((const unsigned*)(_base + offA0), (__attribute__((address_space(3))) unsigned*)((char*)(P) + tid16), 16, 0, 0); \
    __builtin_amdgcn_global_load_lds((const unsigned*)(_base + offA1), (__attribute__((address_space(3))) unsigned*)((char*)(P) + tid16 + 8192), 16, 0, 0); } while (0)
#define STAGE_B(P, hh, kt) do { const bf16_t* _base = Bt + (size_t)(hh) * HALF * ldb + (size_t)(kt) * BK; \
    __builtin_amdgcn_global_load_lds((const unsigned*)(_base + offB0), (__attribute__((address_space(3))) unsigned*)((char*)(P) + tid16), 16, 0, 0); \
    __builtin_amdgcn_global_load_lds((const unsigned*)(_base + offB1), (__attribute__((address_space(3))) unsigned*)((char*)(P) + tid16 + 8192), 16, 0, 0); } while (0)
#define LDA(dst, b, h) for (int m = 0; m < 4; ++m) for (int k = 0; k < 2; ++k) \
    dst[m][k] = *reinterpret_cast<const bf16x8*>((char*)SA(b, h) + lds_byte(wr * 64 + m * 16 + fr, k * 32 + fq * 8))
#define LDB(dst, b, h) for (int n = 0; n < 2; ++n) for (int k = 0; k < 2; ++k) \
    dst[n][k] = *reinterpret_cast<const bf16x8*>((char*)SB(b, h) + lds_byte(wc * 32 + n * 16 + fr, k * 32 + fq * 8))
#define MMA(ai, bj, At, Bt_) do { __builtin_amdgcn_s_setprio(1); \
    for (int m = 0; m < 4; ++m) for (int n = 0; n < 2; ++n) for (int k = 0; k < 2; ++k) { \
      if (SWAP) acc[ai][bj][m][n] = __builtin_amdgcn_mfma_f32_16x16x32_bf16(Bt_[n][k], At[m][k], acc[ai][bj][m][n], 0, 0, 0); \
      else      acc[ai][bj][m][n] = __builtin_amdgcn_mfma_f32_16x16x32_bf16(At[m][k], Bt_[n][k], acc[ai][bj][m][n], 0, 0, 0); } \
    __builtin_amdgcn_s_setprio(0); } while (0)
#define WAIT_V(n) asm volatile("s_waitcnt vmcnt(" #n ")" ::: "memory")
#define WAIT_L(n) asm volatile("s_waitcnt lgkmcnt(" #n ")" ::: "memory")
#define BAR __builtin_amdgcn_s_barrier()
#define SCHED __builtin_amdgcn_sched_barrier(0)
  const int tid = tidx(p), tid16 = tid * 16;
  int R0, C0, R1, C1; stage_rc(tid16, R0, C0); stage_rc(tid16 + 8192, R1, C1);
  const size_t offA0 = (size_t)R0 * lda + C0, offA1 = (size_t)R1 * lda + C1;
  const size_t offB0 = (size_t)R0 * ldb + C0, offB1 = (size_t)R1 * ldb + C1;
  const int wid = tid >> 6, lane = tid & 63, wr = wid >> 2, wc = wid & 3, fr = lane & 15, fq = lane >> 4;
  f32x4 acc[2][2][4][2] = {};
  bf16x8 At[4][2], B0[2][2], B1[2][2];
  WAIT_V(0);
  STAGE_B(SB(0, 0), 0, 0); STAGE_A(SA(0, 0), 0, 0);
  STAGE_B(SB(0, 1), 1, 0); STAGE_A(SA(0, 1), 1, 0);
  if (wr == 1) BAR;
  WAIT_V(4); BAR;
  STAGE_B(SB(1, 0), 0, 1); STAGE_A(SA(1, 0), 0, 1); STAGE_B(SB(1, 1), 1, 1);
  WAIT_V(6); BAR;
  for (int t = 0; t < nt - 2; t += 2) {
    LDB(B0, 0, 0); SCHED; LDA(At, 0, 0); STAGE_A(SA(1, 1), 1, t + 1);
    WAIT_L(8); BAR; WAIT_L(0); MMA(0, 0, At, B0); BAR; SCHED;
    LDB(B1, 0, 1); STAGE_B(SB(0, 0), 0, t + 2);
    BAR; WAIT_L(0); MMA(0, 1, At, B1); BAR;
    LDA(At, 0, 1); STAGE_A(SA(0, 0), 0, t + 2);
    BAR; WAIT_L(0); MMA(1, 0, At, B0); BAR; SCHED;
    STAGE_B(SB(0, 1), 1, t + 2);
    WAIT_V(6); BAR; MMA(1, 1, At, B1); BAR;
    LDB(B0, 1, 0); SCHED; LDA(At, 1, 0); STAGE_A(SA(0, 1), 1, t + 2);
    WAIT_L(8); BAR; WAIT_L(0); MMA(0, 0, At, B0); BAR; SCHED;
    LDB(B1, 1, 1); STAGE_B(SB(1, 0), 0, t + 3);
    BAR; WAIT_L(0); MMA(0, 1, At, B1); BAR;
    LDA(At, 1, 1); STAGE_A(SA(1, 0), 0, t + 3);
    BAR; WAIT_L(0); MMA(1, 0, At, B0); BAR; SCHED;
    STAGE_B(SB(1, 1), 1, t + 3);
    WAIT_V(6); BAR; MMA(1, 1, At, B1); BAR;
  }
  { LDB(B0, 0, 0); LDA(At, 0, 0); STAGE_A(SA(1, 1), 1, nt - 1);
    BAR; WAIT_L(0); MMA(0, 0, At, B0); BAR;
    LDB(B1, 0, 1); BAR; WAIT_L(0); MMA(0, 1, At, B1); BAR;
    LDA(At, 0, 1); WAIT_V(4); BAR; WAIT_L(0); MMA(1, 0, At, B0); MMA(1, 1, At, B1); BAR; }
  { LDB(B0, 1, 0); LDA(At, 1, 0); WAIT_V(2); BAR; WAIT_L(0); MMA(0, 0, At, B0); BAR;
    LDB(B1, 1, 1); WAIT_V(0); BAR; WAIT_L(0); MMA(0, 1, At, B1); BAR;
    LDA(At, 1, 1); BAR; WAIT_L(0); MMA(1, 0, At, B0); MMA(1, 1, At, B1); BAR; }
  if (wr == 0) BAR;
#pragma unroll
  for (int ai = 0; ai < 2; ++ai)
#pragma unroll
    for (int bj = 0; bj < 2; ++bj)
#pragma unroll
      for (int m = 0; m < 4; ++m)
#pragma unroll
        for (int n = 0; n < 2; ++n) {
          if (SWAP) epi(ai * HALF + wr * 64 + m * 16 + fr, bj * HALF + wc * 32 + n * 16 + fq * 4, acc[ai][bj][m][n]);
          else      epi(ai * HALF + wr * 64 + m * 16 + fq * 4, bj * HALF + wc * 32 + n * 16 + fr, acc[ai][bj][m][n]);
        }
#undef SA
#undef SB
#undef APTR
#undef STAGE_A
#undef STAGE_B
#undef LDA
#undef LDB
#undef MMA
}

DEVINL void knorm_image(const Params& p, int ht, int lanen) {
  const bf16_t* KN = (const bf16_t*)(wsp(p) + OFF_KN); char* K8 = (char*)(wsp(p) + OFF_K8);
  const bf16_t* src = KN + (size_t)ht * 8192 + lanen * 8;
  u32x4 raw[16];
#pragma unroll
  for (int kc = 0; kc < 16; ++kc) raw[kc] = *reinterpret_cast<const u32x4*>(src + kc * 512);
  float ss = 0.f;
#pragma unroll
  for (int kc = 0; kc < 16; ++kc)
#pragma unroll
    for (int j = 0; j < 4; ++j) { const float a = bflo(raw[kc][j]), b = bfhi(raw[kc][j]); ss += a * a + b * b; }
  const float r = rsqrtf(ss * (1.f / 128.f) + EPS);
  char* dst = K8 + (size_t)ht * 6144;
#pragma unroll
  for (int c = 0; c < 4; ++c) {
    f32x16 a, b;
#pragma unroll
    for (int q = 0; q < 2; ++q)
#pragma unroll
      for (int j = 0; j < 4; ++j) {
        const int kca = c * 4 + q, kcb = c * 4 + 2 + q, da = kca * 8 + 2 * j, db = kcb * 8 + 2 * j;
        a[q * 8 + 2 * j] = bflo(raw[kca][j]) * r * p.kn_w[da]; a[q * 8 + 2 * j + 1] = bfhi(raw[kca][j]) * r * p.kn_w[da + 1];
        b[q * 8 + 2 * j] = bflo(raw[kcb][j]) * r * p.kn_w[db]; b[q * 8 + 2 * j + 1] = bfhi(raw[kcb][j]) * r * p.kn_w[db + 1];
      }
    const i32x6 w = pk6(a, b);
    u32x4 wa = {(unsigned)w[0], (unsigned)w[1], (unsigned)w[2], (unsigned)w[3]}; u32x2 wb = {(unsigned)w[4], (unsigned)w[5]};
    *reinterpret_cast<u32x4*>(dst + c * 1024 + lanen * 16) = wa;
    *reinterpret_cast<u32x2*>(dst + 4096 + c * 512 + lanen * 8) = wb;
  }
}
DEVINL void kpe_image(const Params& p, int tile, int lanen) {
  const bf16_t* KPE = (const bf16_t*)(wsp(p) + OFF_KPE); char* KP8 = (char*)(wsp(p) + OFF_KP8);
  const bf16_t* src = KPE + (size_t)tile * 4096 + lanen * 8;
  float f[64];
#pragma unroll
  for (int kc = 0; kc < 8; ++kc) { const u32x4 w = *reinterpret_cast<const u32x4*>(src + kc * 512);
#pragma unroll
    for (int j = 0; j < 4; ++j) { f[kc * 8 + 2 * j] = bflo(w[j]); f[kc * 8 + 2 * j + 1] = bfhi(w[j]); } }
  float ss = 0.f;
#pragma unroll
  for (int d = 0; d < 64; ++d) ss += f[d] * f[d];
  const float r = rsqrtf(ss * (1.f / 64.f) + EPS);
  const float pos = (float)(tile * 64 + lanen);
  f32x16 a0, b0, a1, b1;
#pragma unroll
  for (int i = 0; i < 32; ++i) {
    const float x1 = f[i] * r * p.kpe_w[i], x2 = f[i + 32] * r * p.kpe_w[i + 32];
    const float invf = exp2f(-(float)i * (13.287712379549449f / 32.f));
    const float ang = pos * invf;
    const float k = rintf(ang * 0.15915494309189535f);
    float rr = fmaf(-k, 6.2831855f, ang); rr = fmaf(-k, -1.7484555e-7f, rr);
    const float c = __cosf(rr), s = __sinf(rr);
    const float y1 = x1 * c - x2 * s, y2 = x2 * c + x1 * s;
    if (i < 16) { a0[i] = y1; a1[i] = y2; } else { b0[i - 16] = y1; b1[i - 16] = y2; }
  }
  char* dst = KP8 + (size_t)tile * 3072;
  const i32x6 w0 = pk6(a0, b0), w1 = pk6(a1, b1);
  u32x4 wa0 = {(unsigned)w0[0], (unsigned)w0[1], (unsigned)w0[2], (unsigned)w0[3]}, wa1 = {(unsigned)w1[0], (unsigned)w1[1], (unsigned)w1[2], (unsigned)w1[3]};
  u32x2 wb0 = {(unsigned)w0[4], (unsigned)w0[5]}, wb1 = {(unsigned)w1[4], (unsigned)w1[5]};
  *reinterpret_cast<u32x4*>(dst + lanen * 16) = wa0; *reinterpret_cast<u32x4*>(dst + 1024 + lanen * 16) = wa1;
  *reinterpret_cast<u32x2*>(dst + 2048 + lanen * 8) = wb0; *reinterpret_cast<u32x2*>(dst + 2048 + 512 + lanen * 8) = wb1;
}
DEVINL void nak_group(const Params& p, int t, int h) {
  bf16_t* NAK = (bf16_t*)(wsp(p) + OFF_NAK);
  const int blk = t < NMETA ? 0 : 1 + ((t - NMETA) >> 5), r32 = t < NMETA ? t : ((t - NMETA) & 31);
  bf16_t* base = NAK + (size_t)(h * 513 + blk) * 2048 + r32 * 8;
  u32x4 raw[8];
#pragma unroll
  for (int pc = 0; pc < 8; ++pc) raw[pc] = *reinterpret_cast<const u32x4*>(base + pc * 256);
  float ss = 0.f;
#pragma unroll
  for (int pc = 0; pc < 8; ++pc)
#pragma unroll
    for (int j = 0; j < 4; ++j) { const float a = bflo(raw[pc][j]), b = bfhi(raw[pc][j]); ss += a * a + b * b; }
  const float r = rsqrtf(ss * (1.f / 64.f) + EPS);
#pragma unroll
  for (int pc = 0; pc < 8; ++pc) {
    u32x4 o;
#pragma unroll
    for (int j = 0; j < 4; ++j) { const int d = pc * 8 + j * 2; o[j] = cvtpk(bflo(raw[pc][j]) * r * p.nak_w[d], bfhi(raw[pc][j]) * r * p.nak_w[d + 1]); }
    *reinterpret_cast<u32x4*>(base + pc * 256) = o;
  }
}

DEVINL void qn_row(const Params& p, bf16_t* rowp) {
  u32x4 raw[16];
#pragma unroll
  for (int c = 0; c < 16; ++c) raw[c] = *reinterpret_cast<const u32x4*>(rowp + c * 8);
  float ss = 0.f;
#pragma unroll
  for (int c = 0; c < 16; ++c)
#pragma unroll
    for (int j = 0; j < 4; ++j) { const float a = bflo(raw[c][j]), b = bfhi(raw[c][j]); ss += a * a + b * b; }
  const float r = rsqrtf(ss * (1.f / 128.f) + EPS);
#pragma unroll
  for (int ch = 0; ch < 4; ++ch) {
    f32x16 a, b;
#pragma unroll
    for (int q = 0; q < 2; ++q)
#pragma unroll
      for (int j = 0; j < 4; ++j) {
        const int ca = ch * 4 + q, cb = ch * 4 + 2 + q, da = ca * 8 + 2 * j, db = cb * 8 + 2 * j;
        a[q * 8 + 2 * j] = bflo(raw[ca][j]) * r * p.qn_w[da]; a[q * 8 + 2 * j + 1] = bfhi(raw[ca][j]) * r * p.qn_w[da + 1];
        b[q * 8 + 2 * j] = bflo(raw[cb][j]) * r * p.qn_w[db]; b[q * 8 + 2 * j + 1] = bfhi(raw[cb][j]) * r * p.qn_w[db + 1];
      }
    const i32x6 w = pk6(a, b);
    u32x2* d = reinterpret_cast<u32x2*>((char*)rowp + ch * 24);
    d[0] = u32x2{(unsigned)w[0], (unsigned)w[1]}; d[1] = u32x2{(unsigned)w[2], (unsigned)w[3]}; d[2] = u32x2{(unsigned)w[4], (unsigned)w[5]};
  }
}
DEVINL void qr_row(const Params& p, bf16_t* rowp, int posi) {
  float f[64];
#pragma unroll
  for (int c = 0; c < 8; ++c) { const u32x4 w = *reinterpret_cast<const u32x4*>(rowp + c * 8);
#pragma unroll
    for (int j = 0; j < 4; ++j) { f[c * 8 + 2 * j] = bflo(w[j]); f[c * 8 + 2 * j + 1] = bfhi(w[j]); } }
  float ss = 0.f;
#pragma unroll
  for (int d = 0; d < 64; ++d) ss += f[d] * f[d];
  const float r = rsqrtf(ss * (1.f / 64.f) + EPS);
  const float pos = (float)posi;
  f32x16 a0, b0, a1, b1;
#pragma unroll
  for (int i = 0; i < 32; ++i) {
    const float x1 = f[i] * r * p.qpe_w[i], x2 = f[i + 32] * r * p.qpe_w[i + 32];
    const float invf = exp2f(-(float)i * (13.287712379549449f / 32.f));
    const float ang = pos * invf;
    const float k = rintf(ang * 0.15915494309189535f);
    float rr = fmaf(-k, 6.2831855f, ang); rr = fmaf(-k, -1.7484555e-7f, rr);
    const float c = __cosf(rr), s = __sinf(rr);
    const float y1 = x1 * c - x2 * s, y2 = x2 * c + x1 * s;
    if (i < 16) { a0[i] = y1; a1[i] = y2; } else { b0[i - 16] = y1; b1[i - 16] = y2; }
  }
  const i32x6 w0 = pk6(a0, b0), w1 = pk6(a1, b1);
  u32x2* d = reinterpret_cast<u32x2*>(rowp);
  d[0] = u32x2{(unsigned)w0[0], (unsigned)w0[1]}; d[1] = u32x2{(unsigned)w0[2], (unsigned)w0[3]}; d[2] = u32x2{(unsigned)w0[4], (unsigned)w0[5]};
  d[3] = u32x2{(unsigned)w1[0], (unsigned)w1[1]}; d[4] = u32x2{(unsigned)w1[2], (unsigned)w1[3]}; d[5] = u32x2{(unsigned)w1[4], (unsigned)w1[5]};
}

DEVINL void phase_gemm1(const Params& p, char* lds) {
  const bf16_t* Hb = (const bf16_t*)(wsp(p) + OFF_HB); const bf16_t* WinT = (const bf16_t*)(wsp(p) + OFF_WIN);
  const float* r1 = (const float*)(wsp(p) + OFF_R1);
  bf16_t* LAT = (bf16_t*)(wsp(p) + OFF_LAT); bf16_t* KPE = (bf16_t*)(wsp(p) + OFF_KPE);
  bf16_t* NAQ = (bf16_t*)(wsp(p) + OFF_NAQ); bf16_t* NAK = (bf16_t*)(wsp(p) + OFF_NAK); bf16_t* VT = (bf16_t*)(wsp(p) + OFF_VT);
  bf16_t* G = (bf16_t*)p.out;
  constexpr int NM = LP / 256, NN = NPROJ_P / 256;
  constexpr int NT1 = NM * NN, PER_XCD = (NT1 + 7) / 8;
  const int xcd = blockIdx.x & 7, bix = blockIdx.x >> 3, nbx = gridDim.x >> 3;
  for (int i = bix; i < PER_XCD; i += nbx) {
    const int u = xcd * PER_XCD + i;
    if (u >= NT1) break;
    int pm, pn;
    { constexpr int FULL = (NN / 4) * 4 * NM;
      if (u < FULL) { const int s = u / (4 * NM), w = u - s * 4 * NM; pm = w >> 2; pn = s * 4 + (w & 3); }
      else { constexpr int REM = NN - (NN / 4) * 4; const int w = u - FULL; pm = w / REM; pn = (NN / 4) * 4 + (w - pm * REM); } }
    const int brow = pm * 256;
    const bf16_t* A = Hb + (size_t)brow * DM; const bf16_t* B = WinT + (size_t)pn * 256 * DM;
    if (pn >= 14 && pn < 18) {
      const float* rr = r1 + brow;
      gemm_tile<false>(p, A, A, 1 << 30, DM, B, DM, DM / BK, lds, [=](int row, int col, f32x4 v) {
        const int t = brow + row;
        if (t < L) {
          const f32x4 s = *reinterpret_cast<const f32x4*>(rr + row);
          u32x2 w = {cvtpk(v[0] * s[0], v[1] * s[1]), cvtpk(v[2] * s[2], v[3] * s[3])};
          const int cg_ = (pn - 14) * 256 + col, h = cg_ >> 6, db = (cg_ >> 5) & 1, c32 = cg_ & 31;
          const int kb = t < NMETA ? 0 : 1 + ((t - NMETA) >> 4), kin = t < NMETA ? t : ((t - NMETA) & 15);
          *reinterpret_cast<u32x2*>(VT + ((size_t)((h * 1025 + kb) * 2 + db) * 64 + (kin >> 3) * 32 + c32) * 8 + (kin & 7)) = w;
        }
      });
    } else if (pn == 22) {
      gemm_tile<true>(p, A, A, 1 << 30, DM, B, DM, DM / BK, lds, [=](int row, int col, f32x4 v) {
        const int t = brow + row;
        if (col < 64) {
          const float s = r1[t];
          u32x2 w = {cvtpk(v[0] * s, v[1] * s), cvtpk(v[2] * s, v[3] * s)};
          *reinterpret_cast<u32x2*>(KPE + ((size_t)((t >> 6) * 8 + (col >> 3)) * 64 + (t & 63)) * 8 + (col & 7)) = w;
        }
      });
      asm volatile("s_waitcnt vmcnt(0)" ::: "memory"); __syncthreads();
      { const int tid = tidx(p), w = tid >> 6; if (w < 4) kpe_image(p, pm * 4 + w, tid & 63); }
    } else if (pn >= 10 && pn < 14) {
      gemm_tile<true>(p, A, A, 1 << 30, DM, B, DM, DM / BK, lds, [=](int row, int col, f32x4 v) {
        const int t = brow + row;
        if (t < L) {
          const float s = r1[t];
          u32x2 w = {cvtpk(v[0] * s, v[1] * s), cvtpk(v[2] * s, v[3] * s)};
          const int cg_ = (pn - 10) * 256 + col, h = cg_ >> 6, d = cg_ & 63;
          const int blk = t < NMETA ? 0 : 1 + ((t - NMETA) >> 5), r32 = t < NMETA ? t : ((t - NMETA) & 31);
          *reinterpret_cast<u32x2*>(NAK + ((size_t)((h * 513 + blk) * 4 + (d >> 4)) * 64 + ((d >> 3) & 1) * 32 + r32) * 8 + (d & 7)) = w;
        }
      });
      asm volatile("s_waitcnt vmcnt(0)" ::: "memory"); __syncthreads();
      { const int tid = tidx(p), t = brow + (tid & 255);
        if (t < L) { const int h0 = (pn - 10) * 4 + (tid >> 8) * 2; nak_group(p, t, h0); nak_group(p, t, h0 + 1); } }
    } else {
      bf16_t* dst; int ld, rlo = 0, rhi = LP, roff = 0, climit = 256; bool do_silu = false;
      if (pn < 2)        { dst = LAT + pn * 256; ld = 512; }
      else if (pn < 6)   { dst = G + (pn - 2) * 256; ld = 1024; rlo = NMETA; rhi = L; roff = NMETA; do_silu = true; }
      else if (pn < 10)  { dst = NAQ + (pn - 6) * 256; ld = 1024; }
      else if (pn < 22)  { dst = G + (size_t)SEQ * 1024 + (pn - 18) * 256; ld = 1024; rlo = NMETA; rhi = L; roff = NMETA; do_silu = true; }
      else               { dst = KPE; ld = 64; climit = 64; }
      gemm_tile<true>(p, A, A, 1 << 30, DM, B, DM, DM / BK, lds, [=](int row, int col, f32x4 v) {
        const int grow = brow + row;
        if (grow >= rlo && grow < rhi && col < climit) {
          const float s = r1[grow];
          float a = v[0] * s, b = v[1] * s, c = v[2] * s, d = v[3] * s;
          if (do_silu) { a = silu(a); b = silu(b); c = silu(c); d = silu(d); }
          u32x2 w = {cvtpk(a, b), cvtpk(c, d)};
          *reinterpret_cast<u32x2*>(dst + (size_t)(grow - roff) * ld + col) = w;
        }
      });
    }
  }
}

DEVINL void phase_gemm2(const Params& p, char* lds) {
  const bf16_t* LAT = (const bf16_t*)(wsp(p) + OFF_LAT);
  const bf16_t* WuqT = (const bf16_t*)(wsp(p) + OFF_WUQ); const bf16_t* WukvT = (const bf16_t*)(wsp(p) + OFF_WUKV);
  bf16_t* KN = (bf16_t*)(wsp(p) + OFF_KN); bf16_t* V = (bf16_t*)(wsp(p) + OFF_V);
  bf16_t* QN = (bf16_t*)(wsp(p) + OFF_QN); bf16_t* QRp = (bf16_t*)(wsp(p) + OFF_QR);
  float* rs = (float*)(lds + 131072);
  constexpr int T_KV = (LP / 256) * 8, T_Q = (SEQ / 256) * 6;
  const int xcd2 = blockIdx.x & 7, bix2 = blockIdx.x >> 3, nbx2 = gridDim.x >> 3;
  for (int k2 = 0; ; ++k2) {
    const int t = (k2 * 8 + xcd2) * nbx2 + bix2;
    if (t >= T_KV + T_Q) break;
    const bool iskv = t < T_KV;
    int pm, pn; const bf16_t* A;
    if (iskv) { pm = t >> 3; pn = t & 7; A = LAT + (size_t)pm * 256 * 512 + 256; }
    else { const int tt = t - T_KV; pm = tt / 6; pn = tt - pm * 6; A = LAT + (size_t)(pm * 256 + NMETA) * 512; }
    __syncthreads();
    {
      const int row = tidx(p) >> 1, half = tidx(p) & 1;
      const bf16_t* src = A + (size_t)row * 512 + half * 128;
      float ss = 0.f;
#pragma unroll
      for (int i = 0; i < 16; ++i) {
        u32x4 w = *reinterpret_cast<const u32x4*>(src + i * 8);
#pragma unroll
        for (int j = 0; j < 4; ++j) { float a = bflo(w[j]), b = bfhi(w[j]); ss += a * a + b * b; }
      }
      ss += __shfl_xor(ss, 1);
      if (half == 0) rs[row] = rsqrtf(ss * (1.f / 256.f) + EPS);
    }
    __syncthreads();
    const int grow0 = pm * 256;
    if (iskv && pn < 4) {
      gemm_tile<true>(p, A, A, 1 << 30, 512, WukvT + (size_t)pn * 256 * KVR, KVR, KVR / BK, lds, [=](int row, int col, f32x4 v) {
        const float s = rs[row];
        u32x2 w = {cvtpk(v[0] * s, v[1] * s), cvtpk(v[2] * s, v[3] * s)};
        const int t = grow0 + row, tile = t >> 6, k = t & 63, h = pn * 2 + (col >> 7), d = col & 127;
        *reinterpret_cast<u32x2*>(KN + (size_t)h * LP * 128 + ((size_t)(tile * 16 + (d >> 3)) * 64 + k) * 8 + (d & 7)) = w;
      });
      asm volatile("s_waitcnt vmcnt(0)" ::: "memory"); __syncthreads();
      { const int tid = tidx(p), w = tid >> 6; knorm_image(p, (pn * 2 + (w >> 2)) * (LP / 64) + pm * 4 + (w & 3), tid & 63); }
    } else if (iskv) {
      char* V8 = (char*)(wsp(p) + OFF_V);
      gemm_tile<false>(p, A, A, 1 << 30, 512, WukvT + (size_t)pn * 256 * KVR, KVR, KVR / BK, lds, [=](int row, int col, f32x4 v) {
        const int t = grow0 + row, tile = t >> 6, k = t & 63, h = (pn - 4) * 2 + (col >> 7), d = col & 127;
        const int w = pk8(v[0] * rs[row], v[1] * rs[row + 1], v[2] * rs[row + 2], v[3] * rs[row + 3]);
        const int half = k >> 5, g = (k & 31) >> 3, khi = (k >> 2) & 1;
        *reinterpret_cast<int*>(V8 + ((size_t)(h * (LP / 64) + tile)) * 8192 + (((((d >> 5) * 2 + khi) * 2 + half) * 32 + (d & 31)) * 16 + 4 * g)) = w;
      });
    } else if (pn < 4) {
      gemm_tile<true>(p, A, A, 1 << 30, 512, WuqT + (size_t)pn * 256 * QR, QR, QR / BK, lds, [=](int row, int col, f32x4 v) {
        const float s = rs[row];
        u32x2 w = {cvtpk(v[0] * s, v[1] * s), cvtpk(v[2] * s, v[3] * s)};
        const int n = pn * 256 + col, h = n >> 7, d = n & 127;
        *reinterpret_cast<u32x2*>(QN + ((size_t)h * SEQ + grow0 + row) * 128 + d) = w;
      });
      asm volatile("s_waitcnt vmcnt(0)" ::: "memory"); __syncthreads();
      { const int tid = tidx(p); qn_row(p, QN + ((size_t)(pn * 2 + (tid >> 8)) * SEQ + grow0 + (tid & 255)) * 128); }
    } else {
      gemm_tile<true>(p, A, A, 1 << 30, 512, WuqT + (size_t)pn * 256 * QR, QR, QR / BK, lds, [=](int row, int col, f32x4 v) {
        const float s = rs[row];
        u32x2 w = {cvtpk(v[0] * s, v[1] * s), cvtpk(v[2] * s, v[3] * s)};
        const int n = (pn - 4) * 256 + col, h = n >> 6, d = n & 63;
        *reinterpret_cast<u32x2*>(QRp + ((size_t)h * SEQ + grow0 + row) * 64 + d) = w;
      });
      asm volatile("s_waitcnt vmcnt(0)" ::: "memory"); __syncthreads();
      { const int tid = tidx(p), rw_ = grow0 + (tid & 255);
#pragma unroll 1
        for (int hh = 0; hh < 2; ++hh) qr_row(p, QRp + ((size_t)((pn - 4) * 4 + (tid >> 8) * 2 + hh) * SEQ + rw_) * 64, NMETA + rw_); }
    }
  }
}

DEVINL void phase_gemm3(const Params& p, char* lds) {
  const bf16_t* YM = (const bf16_t*)(wsp(p) + OFF_YM); const bf16_t* YN = (const bf16_t*)(wsp(p) + OFF_KN);
  const bf16_t* WoutT = (const bf16_t*)(wsp(p) + OFF_WOUT);
  for (int t = blockIdx.x; t < (SEQ / 256) * 4; t += gridDim.x) {
    const int pm = t % (SEQ / 256), pn = t / (SEQ / 256), brow = pm * 256;
    const float* xr = p.x + (size_t)brow * DM + pn * 256; float* od = p.out + (size_t)brow * DM + pn * 256;
    gemm_tile<true>(p, YM + (size_t)brow * 1024, YN + (size_t)brow * 1024, 16, 1024, WoutT + (size_t)pn * 256 * 2048, 2048, 2048 / BK, lds,
                    [=](int row, int col, f32x4 v) {
      const f32x4 xv = *reinterpret_cast<const f32x4*>(xr + (size_t)row * DM + col);
      f32x4 o = {xv[0] + v[0], xv[1] + v[1], xv[2] + v[2], xv[3] + v[3]};
      *reinterpret_cast<f32x4*>(od + (size_t)row * DM + col) = o;
    });
  }
}

constexpr float MLA_SCALE = 0.07216878364870322f;
constexpr float THR = 2.5f;
constexpr float PSHIFT = 5.f;
constexpr int KVBLK = 64;
constexpr int NT_MLA = 257;
constexpr int SHM_K8 = 9216, SHM_V8 = 8192;
constexpr int LDS_K = 0, LDS_V = 4 * SHM_K8, LDS_AW = LDS_V + 4 * SHM_V8;
using i32x8 = __attribute__((ext_vector_type(8))) int;
#define MFMA8(A, B, C) __builtin_amdgcn_mfma_scale_f32_32x32x64_f8f6f4(A, B, C, 0, 0, 0, 0x7f7f7f7f, 0, 0x7f7f7f7f)
DEVINL i32x8 mk6(int a, int b, int c, int d, int e, int f) { i32x8 r = __builtin_nondeterministic_value(r); r[0] = a; r[1] = b; r[2] = c; r[3] = d; r[4] = e; r[5] = f; return r; }
#define MFMA6(A, B, C) __builtin_amdgcn_mfma_scale_f32_32x32x64_f8f6f4(A, B, C, 2, 2, 0, 0x7f7f7f7f, 0, 0x7f7f7f7f)

DEVINL void partialSM(f32x16& p0, f32x16& p1, float& m_reg, float& mn, float& alpha, int kvalid, int hi) {
  constexpr float C = MLA_SCALE * 1.4426950408889634f;
  if (kvalid < 64) {
#pragma unroll
    for (int r = 0; r < 16; ++r) { if (crow(r, hi) >= kvalid) p0[r] = -1e30f; if (32 + crow(r, hi) >= kvalid) p1[r] = -1e30f; }
  }
  float pmax = p0[0];
#pragma unroll
  for (int r = 1; r < 16; ++r) pmax = fmaxf(pmax, p0[r]);
#pragma unroll
  for (int r = 0; r < 16; ++r) pmax = fmaxf(pmax, p1[r]);
  { auto rr = __builtin_amdgcn_permlane32_swap(__float_as_uint(pmax), __float_as_uint(pmax), false, false);
    pmax = fmaxf(__uint_as_float(rr[0]), __uint_as_float(rr[1])); }
  if (__builtin_expect(__all(pmax - m_reg <= THR / MLA_SCALE), 1)) { mn = m_reg; alpha = 1.f; }
  else { mn = fmaxf(m_reg, pmax); alpha = __builtin_amdgcn_exp2f((m_reg - mn) * C); m_reg = mn; }
  const float mnC = PSHIFT - mn * C;
  const f32x2 C2 = {C, C}, M2 = {mnC, mnC};
#pragma unroll
  for (int r = 0; r < 16; r += 2) { f32x2 v = {p0[r], p0[r + 1]}; v = __builtin_elementwise_fma(v, C2, M2); p0[r] = v[0]; p0[r + 1] = v[1]; }
#pragma unroll
  for (int r = 0; r < 16; r += 2) { f32x2 v = {p1[r], p1[r + 1]}; v = __builtin_elementwise_fma(v, C2, M2); p1[r] = v[0]; p1[r + 1] = v[1]; }
#pragma unroll
  for (int r = 0; r < 16; ++r) p0[r] = __builtin_amdgcn_exp2f(p0[r]);
}
#define PK4(P, BASE, OUT) do { unsigned a0 = cvtpk_v(P[BASE + 0], P[BASE + 1]), a1 = cvtpk_v(P[BASE + 2], P[BASE + 3]);   \
    unsigned b0 = cvtpk_v(P[BASE + 4], P[BASE + 5]), b1 = cvtpk_v(P[BASE + 6], P[BASE + 7]);                              \
    auto r0 = __builtin_amdgcn_permlane32_swap(a0, b0, false, false); auto r1 = __builtin_amdgcn_permlane32_swap(a1, b1, false, false); \
    u32x4 w = {r0[0], r1[0], r0[1], r1[1]}; OUT = *reinterpret_cast<bf16x8*>(&w); } while (0)
template <bool EXPDONE>
DEVINL void finishSM(f32x16& p0, f32x16& p1, float alpha, float& l_reg, i32x8& pa) {
  if (!EXPDONE) {
#pragma unroll
    for (int r = 0; r < 16; ++r) p1[r] = __builtin_amdgcn_exp2f(p1[r]);
  }
#pragma unroll
  for (int i = 0; i < 4; ++i) { pa[i] = pk8(p0[4 * i], p0[4 * i + 1], p0[4 * i + 2], p0[4 * i + 3]); pa[4 + i] = pk8(p1[4 * i], p1[4 * i + 1], p1[4 * i + 2], p1[4 * i + 3]); }
}
template <bool FUSE>
DEVINL void qkt(f32x16& p0, f32x16& p1, const char* Ks, const i32x8* q8, int r32, int hi, f32x16& e1) {
  p0 = f32x16{}; p1 = f32x16{};
  const char* ka = Ks + hi * 1024 + r32 * 16; const char* kb = Ks + 4096 + hi * 512 + r32 * 8;
  const char* ra = Ks + 6144 + hi * 1024 + r32 * 16; const char* rb = Ks + 6144 + 2048 + hi * 512 + r32 * 8;
  u32x4 fa[3][2]; u32x2 fb[3][2];
#define QK_LD(t, slot) do { if ((t) < 2) { \
      fa[slot][0] = *reinterpret_cast<const u32x4*>(ka + (t) * 2048); fa[slot][1] = *reinterpret_cast<const u32x4*>(ka + (t) * 2048 + 512); \
      fb[slot][0] = *reinterpret_cast<const u32x2*>(kb + (t) * 1024); fb[slot][1] = *reinterpret_cast<const u32x2*>(kb + (t) * 1024 + 256); } \
    else { \
      fa[slot][0] = *reinterpret_cast<const u32x4*>(ra); fa[slot][1] = *reinterpret_cast<const u32x4*>(ra + 512); \
      fb[slot][0] = *reinterpret_cast<const u32x2*>(rb); fb[slot][1] = *reinterpret_cast<const u32x2*>(rb + 256); } } while (0)
  QK_LD(0, 0);
#pragma unroll
  for (int t = 0; t < 3; ++t) {
    if (t + 1 < 3) QK_LD(t + 1, (t + 1) % 3);
    const i32x8 a0 = mk6((int)fa[t][0][0], (int)fa[t][0][1], (int)fa[t][0][2], (int)fa[t][0][3], (int)fb[t][0][0], (int)fb[t][0][1]);
    const i32x8 a1 = mk6((int)fa[t][1][0], (int)fa[t][1][1], (int)fa[t][1][2], (int)fa[t][1][3], (int)fb[t][1][0], (int)fb[t][1][1]);
    p0 = MFMA6(a0, q8[t], p0);
    if (FUSE) {
#pragma unroll
      for (int r = 0; r < 3; ++r) { const int rr = t * 6 + r; if (rr < 16) e1[rr] = __builtin_amdgcn_exp2f(e1[rr]); }
    }
    p1 = MFMA6(a1, q8[t], p1);
    if (FUSE) {
#pragma unroll
      for (int r = 3; r < 6; ++r) { const int rr = t * 6 + r; if (rr < 16) e1[rr] = __builtin_amdgcn_exp2f(e1[rr]); }
    }
    SBAR();
  }
#undef QK_LD
}
struct VFrag { u32x4 v[4][2]; };
DEVINL void pv_load(VFrag& f, const char* Vs, int r32, int hi) {
  const char* vb = Vs + hi * 1024 + r32 * 16;
#pragma unroll
  for (int db = 0; db < 4; ++db) { f.v[db][0] = *reinterpret_cast<const u32x4*>(vb + db * 2048); f.v[db][1] = *reinterpret_cast<const u32x4*>(vb + db * 2048 + 512); }
}
DEVINL void pv_mma(f32x16* o, const VFrag& f, const i32x8& pa) {
#pragma unroll
  for (int db = 0; db < 4; ++db) {
    const i32x8 b = {(int)f.v[db][0][0], (int)f.v[db][0][1], (int)f.v[db][0][2], (int)f.v[db][0][3], (int)f.v[db][1][0], (int)f.v[db][1][1], (int)f.v[db][1][2], (int)f.v[db][1][3]};
    o[db] = MFMA8(pa, b, o[db]);
  }
}

DEVINL void pv_psm(f32x16* o, const VFrag& f, const i32x8& pa, f32x16& lsum, const i32x8& ones8,
                   f32x16& p0, f32x16& p1, float& m_reg, float& mn, float& alpha, int kvalid, int hi) {
  constexpr float C = MLA_SCALE * 1.4426950408889634f;
#define PVM(db) do { const i32x8 b = {(int)f.v[db][0][0], (int)f.v[db][0][1], (int)f.v[db][0][2], (int)f.v[db][0][3], (int)f.v[db][1][0], (int)f.v[db][1][1], (int)f.v[db][1][2], (int)f.v[db][1][3]}; \
    o[db] = MFMA8(pa, b, o[db]); } while (0)
  if (kvalid < 64) {
#pragma unroll
    for (int r = 0; r < 16; ++r) { if (crow(r, hi) >= kvalid) p0[r] = -1e30f; if (32 + crow(r, hi) >= kvalid) p1[r] = -1e30f; }
  }
  PVM(0);
  float pmax = p0[0];
#pragma unroll
  for (int r = 1; r < 16; ++r) pmax = fmaxf(pmax, p0[r]);
  SBAR();
  PVM(1);
#pragma unroll
  for (int r = 0; r < 16; ++r) pmax = fmaxf(pmax, p1[r]);
  { auto rr = __builtin_amdgcn_permlane32_swap(__float_as_uint(pmax), __float_as_uint(pmax), false, false);
    pmax = fmaxf(__uint_as_float(rr[0]), __uint_as_float(rr[1])); }
  SBAR();
  PVM(2);
  if (__builtin_expect(__all(pmax - m_reg <= THR / MLA_SCALE), 1)) { mn = m_reg; alpha = 1.f; }
  else { mn = fmaxf(m_reg, pmax); alpha = __builtin_amdgcn_exp2f((m_reg - mn) * C); m_reg = mn; }
  const float mnC = PSHIFT - mn * C;
  const f32x2 C2 = {C, C}, M2 = {mnC, mnC};
#pragma unroll
  for (int r = 0; r < 16; r += 2) { f32x2 v = {p0[r], p0[r + 1]}; v = __builtin_elementwise_fma(v, C2, M2); p0[r] = v[0]; p0[r + 1] = v[1]; }
  SBAR();
  PVM(3);
#pragma unroll
  for (int r = 0; r < 16; r += 2) { f32x2 v = {p1[r], p1[r + 1]}; v = __builtin_elementwise_fma(v, C2, M2); p1[r] = v[0]; p1[r + 1] = v[1]; }
#pragma unroll
  for (int r = 0; r < 8; ++r) p0[r] = __builtin_amdgcn_exp2f(p0[r]);
  SBAR();
  lsum = MFMA8(ones8, pa, (f32x16{}));
#pragma unroll
  for (int r = 8; r < 16; ++r) p0[r] = __builtin_amdgcn_exp2f(p0[r]);
  SBAR();
#undef PVM
}

DEVINL void mla_block(const Params& p, const bf16_t* __restrict__ Qn, const bf16_t* __restrict__ Qr, const char* __restrict__ K8, const char* __restrict__ Kp8,
                      const char* __restrict__ V8, const bf16_t* __restrict__ Gb, bf16_t* __restrict__ Yb, char* lds, int pos0) {
  const int tid = tidx(p), wid = tid >> 6, lane = tid & 63, r32 = lane & 31, hi = lane >> 5;
  char* V_lds = lds + LDS_V; char* K_lds = lds + LDS_K;
  float* ws = (float*)(lds + LDS_AW) + wid * 64; float* li_l = ws; float* al_l = ws + 32;
  float m_reg = -1e30f, l_reg = 0; f32x16 o[4]; i32x8 q8[3];
  __syncthreads();
  {
    const int row = wid * 32 + r32;
    const char* qn = (const char*)(Qn + (size_t)row * 128); const char* qr = (const char*)(Qr + (size_t)row * 64);
#pragma unroll
    for (int t = 0; t < 3; ++t) {
      const u32x2* s = reinterpret_cast<const u32x2*>(t < 2 ? qn + (t * 2 + hi) * 24 : qr + hi * 24);
      const u32x2 w0 = s[0], w1 = s[1], w2 = s[2];
      q8[t] = mk6((int)w0[0], (int)w0[1], (int)w1[0], (int)w1[1], (int)w2[0], (int)w2[1]);
    }
  }
  SBAR();
#pragma unroll
  for (int d = 0; d < 4; ++d) o[d] = f32x16{};
  const int tid16 = tid * 16;
  const unsigned t16u = (unsigned)tid16;
#define GLDS(gp, lp) __builtin_amdgcn_global_load_lds((const unsigned*)(gp), (__attribute__((address_space(3))) unsigned*)(lp), 16, 0, 0)
#define ISSUE_K(j) do { const int _t = (j) < NT ? (j) : NT - 1; char* _d = K_lds + ((j) & 3) * SHM_K8; if (wid < 6) GLDS(K8 + (size_t)_t * 6144 + t16u, _d + tid16); \
    if (wid < 3) GLDS(Kp8 + (size_t)_t * 3072 + t16u, _d + 6144 + tid16); } while (0)
#define ISSUE_V(j) do { const int _t = (j) < NT ? (j) : NT - 1; GLDS(V8 + (size_t)_t * 8192 + t16u, V_lds + ((j) & 3) * SHM_V8 + tid16); } while (0)
#define KS(j) (K_lds + ((j) & 3) * SHM_K8)
#define VS(j) (V_lds + ((j) & 3) * SHM_V8)
#define TILE_SYNC() do { asm volatile("s_waitcnt vmcnt(0)" ::: "memory"); __syncthreads(); } while (0)
#define RESC(a) do { if (__any((a) < 1.f)) { if (hi == 0) al_l[r32] = (a); asm volatile("s_waitcnt lgkmcnt(0)" ::: "memory"); \
    for (int d = 0; d < 4; ++d) for (int r = 0; r < 16; ++r) o[d][r] *= al_l[crow(r, hi)]; } } while (0)
  f32x16 pA0, pA1, pB0, pB1; float mnA, mnB, alA, alB; i32x8 pa; VFrag vf; constexpr int NT = NT_MLA;
  const i32x8 ones8 = {0x38383838, 0x38383838, 0x38383838, 0x38383838, 0x38383838, 0x38383838, 0x38383838, 0x38383838};
  f32x16 lsum;
#define LSUM() do { lsum = MFMA8(ones8, pa, (f32x16{})); } while (0)
#define LUPD(al) do { l_reg = l_reg * (al) + lsum[0]; } while (0)
  ISSUE_K(0); ISSUE_K(1); ISSUE_K(2); ISSUE_V(0); ISSUE_V(1); TILE_SYNC();
  qkt<false>(pA0, pA1, KS(0), q8, r32, hi, pA1); partialSM(pA0, pA1, m_reg, mnA, alA, 64, hi);
  for (int j = 1; j + 1 < NT; j += 2) {
    ISSUE_K(j + 2); ISSUE_K(j + 3); ISSUE_V(j + 1); ISSUE_V(j + 2); SBAR();
    qkt<true>(pB0, pB1, KS(j), q8, r32, hi, pA1);
    pv_load(vf, VS(j - 1), r32, hi); SBAR();
    finishSM<true>(pA0, pA1, alA, l_reg, pa); SBAR();
    pv_psm(o, vf, pa, lsum, ones8, pB0, pB1, m_reg, mnB, alB, 64, hi);
    LUPD(alA); RESC(alB); SBAR();
    qkt<true>(pA0, pA1, KS(j + 1), q8, r32, hi, pB1);
    pv_load(vf, VS(j), r32, hi); SBAR();
    finishSM<true>(pB0, pB1, alB, l_reg, pa); SBAR();
    { const float alPrev = alB; pv_psm(o, vf, pa, lsum, ones8, pA0, pA1, m_reg, mnA, alA, L - (j + 1) * KVBLK, hi); LUPD(alPrev); }
    TILE_SYNC(); RESC(alA);
  }
  pv_load(vf, VS(NT - 1), r32, hi); SBAR();
  finishSM<false>(pA0, pA1, alA, l_reg, pa); SBAR();
  pv_mma(o, vf, pa); LSUM(); LUPD(alA);
  if (hi == 0) li_l[r32] = l_reg; asm volatile("s_waitcnt lgkmcnt(0)" ::: "memory");
  float rli[16];
#pragma unroll
  for (int r = 0; r < 16; ++r) rli[r] = __builtin_amdgcn_rcpf(li_l[crow(r, hi)]);
  asm volatile("s_waitcnt vmcnt(0)" ::: "memory");
  __syncthreads();
  float* ost = (float*)(lds + wid * 16384);
  {
    float* ow = ost + (4 * hi) * 128 + r32;
#pragma unroll
    for (int r = 0; r < 16; ++r)
#pragma unroll
      for (int d0 = 0; d0 < 4; ++d0) ow[((r & 3) + 8 * (r >> 2)) * 128 + d0 * 32] = o[d0][r] * rli[r];
  }
  asm volatile("s_waitcnt lgkmcnt(0)" ::: "memory");
  for (int it = 0; it < 8; ++it) {
    const int c = it * 64 + lane, row = c >> 4, col = (c & 15) * 8;
    const f32x4 a = *reinterpret_cast<const f32x4*>(ost + row * 128 + col), bq = *reinterpret_cast<const f32x4*>(ost + row * 128 + col + 4);
    const size_t off = (size_t)(wid * 32 + row) * 1024 + col;
    const u32x4 g = *reinterpret_cast<const u32x4*>(Gb + off);
    u32x4 y = {cvtpk(a[0] * bflo(g[0]), a[1] * bfhi(g[0])), cvtpk(a[2] * bflo(g[1]), a[3] * bfhi(g[1])),
               cvtpk(bq[0] * bflo(g[2]), bq[1] * bfhi(g[2])), cvtpk(bq[2] * bflo(g[3]), bq[3] * bfhi(g[3]))};
    *reinterpret_cast<u32x4*>(Yb + off) = y;
  }
#undef LSUM
#undef LUPD
#undef GLDS
#undef ISSUE_K
#undef ISSUE_V
#undef KS
#undef VS
#undef TILE_SYNC
#undef RESC
}

constexpr float LOG2E = 1.4426950408889634f;
constexpr float NA_THR = 12.f;
template <int QH>
DEVINL void na_half(const char* kbase, const char* vbase, char* qbase, const char* gbase, char* ybase, const char* tab  ,
                    const float* metab_h, const float* __restrict__ qw, int r0, int r32, int hi, unsigned loff) {
  const int qc = QH * 32 + r32;
  const unsigned qoff = (unsigned)qc * 2048u + (unsigned)hi * 16u;
  bf16x8 qf[4];
  {
    u32x4 raw[4];
#pragma unroll
    for (int d0 = 0; d0 < 4; ++d0) raw[d0] = *reinterpret_cast<const u32x4*>(qbase + qoff + d0 * 32);
    float ss = 0.f;
#pragma unroll
    for (int d0 = 0; d0 < 4; ++d0)
#pragma unroll
      for (int j = 0; j < 4; ++j) { const float a = bflo(raw[d0][j]), b = bfhi(raw[d0][j]); ss += a * a + b * b; }
    { auto rr = __builtin_amdgcn_permlane32_swap(__float_as_uint(ss), __float_as_uint(ss), false, false);
      ss = __uint_as_float(rr[0]) + __uint_as_float(rr[1]); }
    const float rq = rsqrtf(ss * (1.f / 64.f) + EPS) * 0.125f;
#pragma unroll
    for (int d0 = 0; d0 < 4; ++d0) {
      const f32x4 w0 = *reinterpret_cast<const f32x4*>(qw + d0 * 16 + hi * 8), w1 = *reinterpret_cast<const f32x4*>(qw + d0 * 16 + hi * 8 + 4);
      u32x4 o = {cvtpk(bflo(raw[d0][0]) * rq * w0[0], bfhi(raw[d0][0]) * rq * w0[1]), cvtpk(bflo(raw[d0][1]) * rq * w0[2], bfhi(raw[d0][1]) * rq * w0[3]),
                 cvtpk(bflo(raw[d0][2]) * rq * w1[0], bfhi(raw[d0][2]) * rq * w1[1]), cvtpk(bflo(raw[d0][3]) * rq * w1[2], bfhi(raw[d0][3]) * rq * w1[3])};
      qf[d0] = *reinterpret_cast<bf16x8*>(&o);
    }
  }
  const int c0 = min(max(qc - 8, 0), 48);
  int ad[20];
#pragma unroll
  for (int i = 0; i < 20; ++i) {
    const int kc = i < 16 ? QH * 32 + crow(i, hi) : (QH == 0 ? 32 + crow(i - 16, hi) : crow(12 + (i - 16), hi));
    ad[i] = ((kc >= c0 && kc < c0 + 16) ? kc - qc + 15 : 31) * 4;
  }
  float m = -1e30f, l = 0.f; f32x16 o0 = {}, o1 = {};
  bf16x8 kf[8], vf[6];
  { const char* kp = kbase + (size_t)(1 + r0 * 2) * 4 * 1024;
#pragma unroll
    for (int i = 0; i < 8; ++i) kf[i] = *reinterpret_cast<const bf16x8*>(kp + loff + i * 1024); }
#pragma unroll 1
  for (int step = 0; step < 8; ++step) {
    f32x16 s0 = {}, s1 = {};
#pragma unroll
    for (int d0 = 0; d0 < 4; ++d0) {
      s0 = __builtin_amdgcn_mfma_f32_32x32x16_bf16(kf[d0], qf[d0], s0, 0, 0, 0);
      s1 = __builtin_amdgcn_mfma_f32_32x32x16_bf16(kf[4 + d0], qf[d0], s1, 0, 0, 0);
    }
    SBAR();
    { const char* kp = kbase + (step < 7 ? (size_t)(1 + (r0 + step + 1) * 2) * 4 * 1024 : (size_t)0);
#pragma unroll
      for (int i = 0; i < 8; ++i) kf[i] = *reinterpret_cast<const bf16x8*>(kp + loff + i * 1024); }
    { const char* vp = vbase + (size_t)(1 + (r0 + step) * 4 + QH) * 2 * 1024;
#pragma unroll
      for (int i = 0; i < 6; ++i) vf[i] = *reinterpret_cast<const bf16x8*>(vp + loff + i * 1024); }
    SBAR();
    const char* tb = tab + step * 128;
    float e[20];
    float pmax = -1e30f;
#pragma unroll
    for (int i = 0; i < 20; ++i) {
      const float sv = i < 16 ? (QH == 0 ? s0[i] : s1[i]) : (QH == 0 ? s1[i - 16] : s0[12 + (i - 16)]);
      e[i] = fmaf(sv, LOG2E, *reinterpret_cast<const float*>(tb + ad[i]));
      pmax = fmaxf(pmax, e[i]);
    }
    { auto rr = __builtin_amdgcn_permlane32_swap(__float_as_uint(pmax), __float_as_uint(pmax), false, false);
      pmax = fmaxf(__uint_as_float(rr[0]), __uint_as_float(rr[1])); }
    if (!__all(pmax - m <= NA_THR)) {
      const float mn = fmaxf(m, pmax), alpha = __builtin_amdgcn_exp2f(m - mn); m = mn;
      l *= alpha;
#pragma unroll
      for (int reg = 0; reg < 16; ++reg) { o0[reg] *= alpha; o1[reg] *= alpha; }
    }
    float ps = 0.f;
#pragma unroll
    for (int i = 0; i < 20; ++i) { e[i] = __builtin_amdgcn_exp2f(e[i] - m); ps += e[i]; }
    { auto rr = __builtin_amdgcn_permlane32_swap(__float_as_uint(ps), __float_as_uint(ps), false, false);
      ps = __uint_as_float(rr[0]) + __uint_as_float(rr[1]); }
    l += ps;
    float pd[16], px[8];
#pragma unroll
    for (int i = 0; i < 16; ++i) pd[i] = e[i];
#pragma unroll
    for (int i = 0; i < 8; ++i) px[i] = QH == 0 ? (i < 4 ? e[16 + i] : 0.f) : (i >= 4 ? e[16 + (i - 4)] : 0.f);
    bf16x8 pa0, pa1, pa2;
    if (QH == 0) { PK4(pd, 0, pa0); PK4(pd, 8, pa1); PK4(px, 0, pa2); }
    else         { PK4(px, 0, pa0); PK4(pd, 0, pa1); PK4(pd, 8, pa2); }
    o0 = __builtin_amdgcn_mfma_f32_32x32x16_bf16(vf[0], pa0, o0, 0, 0, 0); o1 = __builtin_amdgcn_mfma_f32_32x32x16_bf16(vf[1], pa0, o1, 0, 0, 0);
    o0 = __builtin_amdgcn_mfma_f32_32x32x16_bf16(vf[2], pa1, o0, 0, 0, 0); o1 = __builtin_amdgcn_mfma_f32_32x32x16_bf16(vf[3], pa1, o1, 0, 0, 0);
    o0 = __builtin_amdgcn_mfma_f32_32x32x16_bf16(vf[4], pa2, o0, 0, 0, 0); o1 = __builtin_amdgcn_mfma_f32_32x32x16_bf16(vf[5], pa2, o1, 0, 0, 0);
  }
  {
    vf[0] = *reinterpret_cast<const bf16x8*>(vbase + loff); vf[1] = *reinterpret_cast<const bf16x8*>(vbase + loff + 1024);
    f32x16 s0 = {};
#pragma unroll
    for (int d0 = 0; d0 < 4; ++d0) s0 = __builtin_amdgcn_mfma_f32_32x32x16_bf16(kf[d0], qf[d0], s0, 0, 0, 0);
    float e[8];
    float pmax = -1e30f;
#pragma unroll
    for (int i = 0; i < 8; ++i) { e[i] = fmaf(s0[i], LOG2E, metab_h[crow(i, hi)]); pmax = fmaxf(pmax, e[i]); }
    { auto rr = __builtin_amdgcn_permlane32_swap(__float_as_uint(pmax), __float_as_uint(pmax), false, false);
      pmax = fmaxf(__uint_as_float(rr[0]), __uint_as_float(rr[1])); }
    if (!__all(pmax - m <= NA_THR)) {
      const float mn = fmaxf(m, pmax), alpha = __builtin_amdgcn_exp2f(m - mn); m = mn;
      l *= alpha;
#pragma unroll
      for (int reg = 0; reg < 16; ++reg) { o0[reg] *= alpha; o1[reg] *= alpha; }
    }
    float ps = 0.f;
#pragma unroll
    for (int i = 0; i < 8; ++i) { e[i] = __builtin_amdgcn_exp2f(e[i] - m); ps += e[i]; }
    { auto rr = __builtin_amdgcn_permlane32_swap(__float_as_uint(ps), __float_as_uint(ps), false, false);
      ps = __uint_as_float(rr[0]) + __uint_as_float(rr[1]); }
    l += ps;
    bf16x8 pa0;
    PK4(e, 0, pa0);
    o0 = __builtin_amdgcn_mfma_f32_32x32x16_bf16(vf[0], pa0, o0, 0, 0, 0);
    o1 = __builtin_amdgcn_mfma_f32_32x32x16_bf16(vf[1], pa0, o1, 0, 0, 0);
  }
  const float rl = __builtin_amdgcn_rcpf(l);
  const unsigned eoff = (unsigned)qc * 2048u + (unsigned)hi * 8u;
#pragma unroll
  for (int q4 = 0; q4 < 4; ++q4) {
    const u32x2 g0 = *reinterpret_cast<const u32x2*>(gbase + eoff + q4 * 16), g1 = *reinterpret_cast<const u32x2*>(gbase + eoff + 64 + q4 * 16);
    u32x2 w0 = {cvtpk(o0[4 * q4 + 0] * rl * bflo(g0[0]), o0[4 * q4 + 1] * rl * bfhi(g0[0])), cvtpk(o0[4 * q4 + 2] * rl * bflo(g0[1]), o0[4 * q4 + 3] * rl * bfhi(g0[1]))};
    u32x2 w1 = {cvtpk(o1[4 * q4 + 0] * rl * bflo(g1[0]), o1[4 * q4 + 1] * rl * bfhi(g1[0])), cvtpk(o1[4 * q4 + 2] * rl * bflo(g1[1]), o1[4 * q4 + 3] * rl * bfhi(g1[1]))};
    *reinterpret_cast<u32x2*>(ybase + eoff + q4 * 16) = w0; *reinterpret_cast<u32x2*>(ybase + eoff + 64 + q4 * 16) = w1;
  }
}
DEVINL void na_item(const Params& p, int r, int h, int qh, const float* relb_l, const float* metab_l) {
  const int lane = tidx(p) & 63, r32 = lane & 31, hi = lane >> 5;
  const int r0 = min(max(r - 4, 0), 256 - 8);
  const char* kbase = (const char*)(wsp(p) + OFF_NAK) + (size_t)h * 513 * 4 * 1024;
  const char* vbase = (const char*)(wsp(p) + OFF_VT) + (size_t)h * 1025 * 2 * 1024;
  char* qbase = (char*)(wsp(p) + OFF_NAQ) + ((size_t)(NMETA + r * 64) * 1024 + h * 64) * 2;
  const char* gbase = (const char*)p.out + ((size_t)SEQ * 1024 + (size_t)r * 64 * 1024 + h * 64) * 2;
  char* ybase = (char*)(wsp(p) + OFF_KN) + ((size_t)r * 64 * 1024 + h * 64) * 2;
  const unsigned loff = lane * 16;
  const char* tab = (const char*)relb_l + ((h * 15 + (r0 - r + 7)) * 32) * 4;
  if (qh == 0) na_half<0>(kbase, vbase, qbase, gbase, ybase, tab, metab_l + h * 16, p.naq_w, r0, r32, hi, loff);
  else         na_half<1>(kbase, vbase, qbase, gbase, ybase, tab, metab_l + h * 16, p.naq_w, r0, r32, hi, loff);
}

DEVINL void phase_attn(const Params& p, char* lds) {
#ifndef NO_MLA
  {
    const bf16_t* QN = (const bf16_t*)(wsp(p) + OFF_QN); const bf16_t* QRp = (const bf16_t*)(wsp(p) + OFF_QR);
    const char* K8 = (const char*)(wsp(p) + OFF_K8); const char* KP8 = (const char*)(wsp(p) + OFF_KP8); const char* V8 = (const char*)(wsp(p) + OFF_V);
    const bf16_t* G = (const bf16_t*)p.out; bf16_t* YM = (bf16_t*)(wsp(p) + OFF_YM);
    for (int it = blockIdx.x; it < 512; it += gridDim.x) {
      const int h = it & 7, qb = it >> 3;
      mla_block(p, QN + ((size_t)h * SEQ + qb * 256) * 128, QRp + ((size_t)h * SEQ + qb * 256) * 64, K8 + (size_t)h * (LP / 64) * 6144, KP8, V8 + (size_t)h * (LP / 64) * 8192,
                G + (size_t)qb * 256 * 1024 + h * 128, YM + (size_t)qb * 256 * 1024 + h * 128, lds, NMETA + qb * 256);
    }
  }
#endif
#ifndef NO_NA
  __syncthreads();
  float* relb_l = (float*)lds; float* metab_l = relb_l + 16 * 15 * 32;
  for (int i = tidx(p); i < 16 * 15 * 32; i += NTHREADS) { const int dc = i & 31, hd = i >> 5; relb_l[i] = dc < 31 ? p.relb[hd * 31 + dc] * LOG2E : -1e30f; }
  for (int i = tidx(p); i < 256; i += NTHREADS) metab_l[i] = p.metab[i] * LOG2E;
  __syncthreads();
  const int wave = __builtin_amdgcn_readfirstlane(tidx(p) >> 6);
  const int xcdn = blockIdx.x & 7, bixn = blockIdx.x >> 3, nbxn = gridDim.x >> 3;
  for (int i = bixn; i < 128; i += nbxn) {
    const int g = i & 63, h = xcdn * 2 + (i >> 6);
    na_item(p, g * 4 + (wave >> 1), h, wave & 1, relb_l, metab_l);
  }
#endif
}

#define XB_TMO      128
#define XB_XCNT(j)  (256  + 64 * (j))
#define XB_XSUB(j)  (1280 + 64 * (j))
#define XB_XGEN(j)  (2304 + 64 * (j))
#define XB_TOP      3328
#define XB_TOPGEN   3392
#define XB_SPIN_CAP (1u << 22)
DEVINL unsigned xb_ld(unsigned* q)              { return __hip_atomic_load(q, __ATOMIC_RELAXED, __HIP_MEMORY_SCOPE_AGENT); }
DEVINL unsigned xb_add(unsigned* q, unsigned v) { return __hip_atomic_fetch_add(q, v, __ATOMIC_RELAXED, __HIP_MEMORY_SCOPE_AGENT); }
DEVINL unsigned xb_xcc_id() { return (unsigned)__builtin_amdgcn_s_getreg((3 << 11) | 20) & 0xFu; }
#define XB_SPIN(cond, bar) do { unsigned _sp = 0; while (cond) { __builtin_amdgcn_s_sleep(1); \
    if ((++_sp & 255u) == 0u) { if (xb_ld(&(bar)[XB_TMO])) break; if (_sp > XB_SPIN_CAP) { atomicAdd(&(bar)[XB_TMO], 1u); break; } } } } while (0)
DEVINL void xcd_barrier_post(const Params& p, unsigned* bar, volatile unsigned* st) {
  if (tidx(p) == 0) { st[0] = 0u; st[1] = 0u; (void)xb_add(&bar[XB_XCNT(xb_xcc_id())], 1u); }
  __syncthreads();
}
DEVINL void xcd_barrier_complete(unsigned* bar, unsigned x, unsigned& nloc, unsigned& nx) {
  const unsigned G = gridDim.x;
  unsigned sum, cnt, mine, sp = 0u;
  for (;;) {
    sum = 0u; cnt = 0u; mine = 0u;
#pragma unroll
    for (unsigned j = 0; j < 16; ++j) { const unsigned c = xb_ld(&bar[XB_XCNT(j)]); sum += c; cnt += (c > 0u) ? 1u : 0u; mine = (j == x) ? c : mine; }
    if (sum == G) break;
    __builtin_amdgcn_s_sleep(1);
    if ((++sp & 255u) == 0u) { if (xb_ld(&bar[XB_TMO])) break; if (sp > XB_SPIN_CAP) { atomicAdd(&bar[XB_TMO], 1u); break; } }
  }
  nloc = mine > 0u ? mine : 1u; nx = cnt > 0u ? cnt : 1u;
}
DEVINL void grid_barrier(const Params& p, unsigned* bar, volatile unsigned* st) {
  asm volatile("s_waitcnt vmcnt(0) lgkmcnt(0)" ::: "memory");
  __syncthreads();
  if (tidx(p) == 0) {
    const unsigned x = xb_xcc_id();
    __builtin_amdgcn_s_waitcnt(0);
    unsigned nloc = st[0], nx = st[1];
    if (nloc == 0u) { xcd_barrier_complete(bar, x, nloc, nx); st[0] = nloc; st[1] = nx; }
    const unsigned old = xb_add(&bar[XB_XSUB(x)], 1u);
    const unsigned gen = old / nloc;
    if (old + 1u == (gen + 1u) * nloc) {
      __builtin_amdgcn_fence(__ATOMIC_RELEASE, "agent");
      asm volatile("s_waitcnt vmcnt(0)" ::: "memory");
      const unsigned og = xb_add(&bar[XB_TOP], 1u);
      const unsigned tg = og / nx;
      if (og + 1u == (tg + 1u) * nx) xb_add(&bar[XB_TOPGEN], 1u);
      else XB_SPIN(xb_ld(&bar[XB_TOPGEN]) == tg, bar);
      __builtin_amdgcn_fence(__ATOMIC_ACQUIRE, "agent");
      xb_add(&bar[XB_XGEN(x)], 1u);
      asm volatile("s_waitcnt vmcnt(0)" ::: "memory");
    } else {
      XB_SPIN(xb_ld(&bar[XB_XGEN(x)]) == gen, bar);
      __builtin_amdgcn_fence(__ATOMIC_ACQUIRE, "agent");
      asm volatile("s_waitcnt vmcnt(0)" ::: "memory");
    }
  }
  __syncthreads();
}

__global__ void __launch_bounds__(NTHREADS) mega(Params p, int ph_lo, int ph_hi) {
  extern __shared__ __attribute__((aligned(16))) char shm[];
  if (ph_hi > 64) cg::this_grid().sync();
  p.tid0 = __builtin_amdgcn_readfirstlane((int)threadIdx.x);
  volatile unsigned* xst = (volatile unsigned*)(shm + LDS_XB);
  xcd_barrier_post(p, (unsigned*)(wsp(p) + OFF_BAR), xst);
#define SEAM(k) do { if (ph_lo < (k) && (k) < ph_hi) grid_barrier(p, (unsigned*)(wsp(p) + OFF_BAR), xst); } while (0)
#define RUNS(k) (ph_lo <= (k) && (k) < ph_hi)
#ifdef ONLY_PHASE
  if (ONLY_PHASE == 0) phase_prep(p, shm);
  if (ONLY_PHASE == 1) phase_gemm1(p, shm);
  if (ONLY_PHASE == 2) phase_gemm2(p, shm);
  if (ONLY_PHASE == 4) phase_attn(p, shm);
  if (ONLY_PHASE == 5) phase_gemm3(p, shm);
#else
  if (RUNS(0)) phase_prep(p, shm);
  SEAM(1);
  if (RUNS(1)) phase_gemm1(p, shm);
  SEAM(2);
  if (RUNS(2)) phase_gemm2(p, shm);
  SEAM(4);
  if (RUNS(4)) phase_attn(p, shm);
  SEAM(5);
  if (RUNS(5)) phase_gemm3(p, shm);
#endif
#undef SEAM
#undef RUNS
}

extern "C" void kernel_launch(void* const* d_in, const int* in_sizes, int n_in, void* d_out, int out_size, void* d_ws, size_t ws_size, hipStream_t stream) {
  static int grid = 0;
  if (grid == 0) {
    if (n_in != 17 || in_sizes[0] != SEQ * DM || out_size != SEQ * DM || ws_size < WS_END) {
      fprintf(stderr, "kernel_launch: shape mismatch n_in %d in0 %d out %d ws %zu (need %zu)\n", n_in, n_in > 0 ? in_sizes[0] : -1, out_size, ws_size, (size_t)WS_END);
      grid = -1; return; }
    int dev = 0, cus = 0, per_cu = 0;
    hipGetDevice(&dev);
    hipDeviceGetAttribute(&cus, hipDeviceAttributeMultiprocessorCount, dev);
    if (hipFuncSetAttribute((const void*)mega, hipFuncAttributeMaxDynamicSharedMemorySize, LDS_BYTES) != hipSuccess) { fprintf(stderr, "kernel_launch: hipFuncSetAttribute failed\n"); grid = -1; return; }
    if (hipOccupancyMaxActiveBlocksPerMultiprocessor(&per_cu, (const void*)mega, NTHREADS, LDS_BYTES) != hipSuccess || per_cu < 1) {
      fprintf(stderr, "kernel_launch: occupancy query gave %d\n", per_cu); (void)hipGetLastError(); per_cu = 1; }
    grid = cus * 1;
    if (grid <= 0) grid = 256;
  }
  if (grid < 0) return;
  Params p{};
  const float** f = (const float**)&p;
  for (int i = 0; i < 17; ++i) f[i] = (const float*)d_in[i];
  p.out = (float*)d_out; p.ws = (unsigned char*)d_ws;
#if N_LAUNCHES == 1
  if (hipMemsetAsync((char*)d_ws + OFF_BAR, 0, BAR_BYTES, stream) != hipSuccess) { fprintf(stderr, "kernel_launch: memset of the barrier words failed\n"); return; }
  int lo = 0, hi = 6;
  void* args[] = {&p, &lo, &hi};
  hipError_t e = hipLaunchCooperativeKernel((const void*)mega, dim3(grid), dim3(NTHREADS), args, LDS_BYTES, stream);
  if (e != hipSuccess) fprintf(stderr, "cooperative launch failed: %s (grid %d)\n", hipGetErrorString(e), grid);
#else
  for (int ph = 0; ph < 6; ++ph) {
    hipLaunchKernelGGL(mega, dim3(grid), dim3(NTHREADS), LDS_BYTES, stream, p, ph, ph + 1);
  }
  hipError_t e = hipPeekAtLastError();
  if (e != hipSuccess) fprintf(stderr, "launch failed: %s\n", hipGetErrorString(e));
#endif
}
```
